# Optimizing an MI355X kernel written in HIP

```python
import jax, jax.numpy as jnp
from jax import lax
import numpy as np

D_MODEL = 2048
BATCH = 16
SEQ = 2048
DEPTH = 1
DEC_BATCH = 8
DEC_SEQ = 32
PAST_LEN = 1024

CHUNK = 64
D_MIX = D_MODEL
D_A = D_MIX // 2
D_B = D_MIX - D_A
N_GROUPS_A = 8
HEAD_DIM_A = D_A // N_GROUPS_A
MLP_CHUNK = 128
CONV_WIDTH = 31
D_FF = 5632
N_MOD = 9
EPS = 1e-6

kernel_name = "hybrid_gmlp_conformer_stream_step"


def rms_norm(x, g):
    xf = x.astype(jnp.float32)
    y = xf * lax.rsqrt(jnp.mean(xf * xf, axis=-1, keepdims=True) + EPS)
    return (y * g.astype(jnp.float32)).astype(x.dtype)


def layer_norm(x, g, b):
    xf = x.astype(jnp.float32)
    mu = jnp.mean(xf, axis=-1, keepdims=True)
    xc = xf - mu
    y = xc * lax.rsqrt(jnp.mean(xc * xc, axis=-1, keepdims=True) + EPS)
    return (y * g.astype(jnp.float32) + b.astype(jnp.float32)).astype(x.dtype)


def swiglu_ffn(h, w_up, w_down):
    gu = h @ w_up
    g, u = jnp.split(gu, 2, axis=-1)
    return (jax.nn.silu(g) * u) @ w_down


def depthwise_causal_conv(xc, w_dw, b_dw):
    out = lax.conv_general_dilated(
        xc, w_dw[:, None, :].astype(xc.dtype), window_strides=(1,), padding='VALID',
        dimension_numbers=('NWC', 'WIO', 'NWC'), feature_group_count=xc.shape[-1])
    return out + b_dw


def _mixing(h, conv_hist, chunk_len, w_in, g_v, w_s_masked, b_s, w_dw, b_dw, g_cn, b_cn,
            g_out_a, g_out_b, w_out):
    z = h @ w_in
    u, v, ga, gb = jnp.split(z, [D_A, 2 * D_A, 2 * D_A + D_B], axis=-1)
    bsz, L, _ = v.shape
    v = rms_norm(v, g_v)
    vr = v.reshape(bsz, L // chunk_len, chunk_len, N_GROUPS_A, HEAD_DIM_A)
    ws = w_s_masked[:, :chunk_len, :chunk_len]
    bias = b_s[:, :chunk_len].T[None, None, :, :, None]
    sp = jnp.einsum('gij,bnjgd->bnigd', ws, vr) + bias
    y_a = u * sp.reshape(bsz, L, D_A)
    glu = ga * jax.nn.sigmoid(gb)
    if conv_hist is None:
        conv_hist = jnp.zeros((bsz, CONV_WIDTH - 1, D_B), glu.dtype)
    xc = jnp.concatenate([conv_hist.astype(glu.dtype), glu], axis=1)
    y_b = jax.nn.silu(layer_norm(depthwise_causal_conv(xc, w_dw, b_dw), g_cn, b_cn))
    new_conv = xc[:, -(CONV_WIDTH - 1):]
    y = jnp.concatenate([rms_norm(y_a, g_out_a), rms_norm(y_b, g_out_b)], axis=-1) @ w_out
    return y, new_conv, v


def _layer(x, c, conv_hist, chunk_len, w_ada, b_ada, g_ffn1, w_up1, w_down1, g_mix, w_in, g_v,
           w_s_masked, b_s, w_dw, b_dw, g_cn, b_cn, g_out_a, g_out_b, w_out, g_ffn2, w_up2, w_down2):
    mod = jax.nn.silu(c) @ w_ada + b_ada
    sh1, sc1, gt1, sh2, sc2, gt2, sh3, sc3, gt3 = [m[:, None, :] for m in jnp.split(mod, N_MOD, axis=-1)]
    h = rms_norm(x, g_ffn1) * (1 + sc1) + sh1
    x = x + 0.5 * gt1 * swiglu_ffn(h, w_up1, w_down1)
    h = rms_norm(x, g_mix) * (1 + sc2) + sh2
    y, new_conv, v = _mixing(h, conv_hist, chunk_len, w_in, g_v, w_s_masked, b_s, w_dw, b_dw,
                             g_cn, b_cn, g_out_a, g_out_b, w_out)
    x = x + gt2 * y
    h = rms_norm(x, g_ffn2) * (1 + sc3) + sh3
    x = x + 0.5 * gt3 * swiglu_ffn(h, w_up2, w_down2)
    return x, new_conv, v


def setup_inputs(seed: int = 0) -> dict:
    key = jax.random.key(seed)
    ks = jax.random.split(key, 32)
    n = lambda k, shape, s: jax.random.normal(k, shape, jnp.float32) * s
    L = DEPTH
    D = D_MODEL
    return {
        "x_prompt": n(ks[0], (BATCH, SEQ, D), 1.0),
        "x_sample": n(ks[1], (DEC_BATCH, DEC_SEQ, D), 1.0),
        "cache_conv": n(ks[2], (L, DEC_BATCH, CONV_WIDTH - 1, D_B), 0.5),
        "c_prompt": n(ks[3], (BATCH, D), 1.0),
        "c_sample": n(ks[4], (DEC_BATCH, D), 1.0),
        "w_ada": n(ks[5], (L, D, N_MOD * D), 0.5 * D ** -0.5),
        "b_ada": n(ks[6], (L, N_MOD * D), 0.02),
        "g_ffn1": 1.0 + n(ks[7], (L, D), 0.02),
        "w_up1": n(ks[8], (L, D, 2 * D_FF), D ** -0.5),
        "w_down1": n(ks[9], (L, D_FF, D), D_FF ** -0.5),
        "g_mix": 1.0 + n(ks[10], (L, D), 0.02),
        "w_in": n(ks[11], (L, D, 2 * D_A + 2 * D_B), D ** -0.5),
        "g_v": 1.0 + n(ks[12], (L, D_A), 0.02),
        "w_s": n(ks[13], (L, N_GROUPS_A, MLP_CHUNK, MLP_CHUNK), MLP_CHUNK ** -0.5),
        "b_s": n(ks[14], (L, N_GROUPS_A, MLP_CHUNK), 0.02),
        "w_dw": n(ks[15], (L, CONV_WIDTH, D_B), CONV_WIDTH ** -0.5),
        "b_dw": n(ks[16], (L, D_B), 0.02),
        "g_cn": 1.0 + n(ks[17], (L, D_B), 0.02),
        "b_cn": n(ks[18], (L, D_B), 0.02),
        "g_out_a": 1.0 + n(ks[19], (L, D_A), 0.02),
        "g_out_b": 1.0 + n(ks[20], (L, D_B), 0.02),
        "w_out": n(ks[21], (L, D_MIX, D), D_MIX ** -0.5),
        "g_ffn2": 1.0 + n(ks[22], (L, D), 0.02),
        "w_up2": n(ks[23], (L, D, 2 * D_FF), D ** -0.5),
        "w_down2": n(ks[24], (L, D_FF, D), D_FF ** -0.5),
        "g_final": 1.0 + n(ks[25], (D,), 0.02),
    }


def reference(x_prompt, x_sample, cache_conv, c_prompt, c_sample, w_ada, b_ada, g_ffn1, w_up1,
              w_down1, g_mix, w_in, g_v, w_s, b_s, w_dw, b_dw, g_cn, b_cn, g_out_a, g_out_b, w_out,
              g_ffn2, w_up2, w_down2, g_final):
    tri = jnp.tril(jnp.ones((MLP_CHUNK, MLP_CHUNK), dtype=w_s.dtype))
    sample_len = x_sample.shape[1]
    xp, xs = x_prompt, x_sample
    conv_p, conv_s, v_s = [], [], []
    for l in range(DEPTH):
        p = (w_ada[l], b_ada[l], g_ffn1[l], w_up1[l], w_down1[l], g_mix[l], w_in[l], g_v[l],
             w_s[l] * tri, b_s[l], w_dw[l], b_dw[l], g_cn[l], b_cn[l], g_out_a[l], g_out_b[l],
             w_out[l], g_ffn2[l], w_up2[l], w_down2[l])
        xp, cp, _ = _layer(xp, c_prompt, None, MLP_CHUNK, *p)
        xs, cs, vs = _layer(xs, c_sample, cache_conv[l], sample_len, *p)
        conv_p.append(cp)
        conv_s.append(cs)
        v_s.append(vs)
    y_prompt = rms_norm(xp, g_final)
    y_sample = rms_norm(xs, g_final)
    return (y_prompt, y_sample, jnp.stack(conv_p), jnp.stack(conv_s), jnp.stack(v_s))
```

```cpp
#include <hip/hip_runtime.h>
#include <hip/hip_cooperative_groups.h>
#include <cstdio>
#include <cstdint>
namespace cg = cooperative_groups;

#ifndef MK_PER_PHASE
#define MK_PER_PHASE 1
#endif

constexpr int D = 2048, NB_P = 16, SEQ = 2048, NB_S = 8, SSEQ = 32;
constexpr int MP = NB_P * SEQ, MS = NB_S * SSEQ, M = MP + MS;
constexpr int DA = 1024, DB = 1024, NG = 8, HD = 128, FF = 5632, NMOD = 9 * D, CW = 31, NBT = NB_P + NB_S;
constexpr float EPS = 1e-6f;
constexpr int OFF_SH1 = 0, OFF_SC1 = D, OFF_GT1 = 2 * D, OFF_SH2 = 3 * D, OFF_SC2 = 4 * D, OFF_GT2 = 5 * D, OFF_SH3 = 6 * D, OFF_SC3 = 7 * D, OFF_GT3 = 8 * D;
constexpr size_t OUT_Y = 0, OUT_CP = (size_t)M * D, OUT_CS = OUT_CP + (size_t)NB_P * 30 * DB, OUT_VS = OUT_CS + (size_t)NB_S * 30 * DB, OUT_END = OUT_VS + (size_t)NB_S * SSEQ * DA;
constexpr size_t MiB = 1u << 20;
constexpr size_t WS_MOD = 0, WS_WSM = 2 * MiB, WS_GLUS = 3 * MiB  , WS_WUP1 = 4 * MiB, WS_WDN1 = 48 * MiB, WS_WIN = 70 * MiB, WS_WOUT = 86 * MiB, WS_WUP2 = 94 * MiB, WS_WDN2 = 138 * MiB;
constexpr size_t WS_H = 160 * MiB, WS_ACT = 289 * MiB, WS_UV = WS_ACT, WS_GLU = WS_ACT + 129 * MiB, WS_END = 644 * MiB;
static_assert((size_t)M * D * 2 <= 129 * MiB && (size_t)M * FF * 2 <= (644 - 289) * MiB, "ws map");
constexpr int LDS_BYTES = 147456;

#define LAS __attribute__((address_space(3)))
typedef unsigned short bf16;
typedef float f32x4 __attribute__((ext_vector_type(4)));
typedef float f32x2 __attribute__((ext_vector_type(2)));
typedef unsigned u32x4 __attribute__((ext_vector_type(4)));
typedef unsigned u32x2 __attribute__((ext_vector_type(2)));

__device__ __forceinline__ unsigned f2bf(float f) { unsigned u = __builtin_bit_cast(unsigned, f); return (u + 0x7fffu + ((u >> 16) & 1u)) >> 16; }
__device__ __forceinline__ unsigned pk2(float lo, float hi) { return f2bf(lo) | (f2bf(hi) << 16); }
__device__ __forceinline__ float bflo(unsigned w) { return __builtin_bit_cast(float, w << 16); }
__device__ __forceinline__ float bfhi(unsigned w) { return __builtin_bit_cast(float, w & 0xffff0000u); }
__device__ __forceinline__ float fsigmoid(float x) { return __builtin_amdgcn_rcpf(1.0f + __builtin_amdgcn_exp2f(-1.4426950408889634f * x)); }
__device__ __forceinline__ float wave_sum(float v) {
#pragma unroll
    for (int o = 1; o < 64; o <<= 1) v += __shfl_xor(v, o);
    return v;
}
__device__ __forceinline__ int fresh_tid() { int t = threadIdx.x; asm volatile("" : "+v"(t)); return t; }
__device__ __forceinline__ int row_batch(int row) { return row < MP ? (row >> 11) : NB_P + ((row - MP) >> 5); }

namespace pg8 {
#define PG8_LAS __attribute__((address_space(3)))
typedef unsigned short bf16_t;
typedef short bf16x8 __attribute__((ext_vector_type(8)));
typedef float f32x4 __attribute__((ext_vector_type(4)));
typedef unsigned u32x4 __attribute__((ext_vector_type(4)));
constexpr int BM = 256, BK = 64, HALF = 128, HTB = HALF * BK * 2  , STAGE_BYTES = 8 * HTB, NXCD = 8, WGM = 8;

__host__ __device__ __forceinline__ int lds_byte(int r, int c) { const int st = (r >> 4) * 2 + (c >> 5), rr = r & 15, cc = c & 31, ob = rr * 64 + cc * 2; return st * 1024 + (ob ^ (((ob >> 9) & 1) << 5)); }
__host__ __device__ __forceinline__ void stage_rc(int b, int& R, int& C) { const int st = b / 1024, sb = b % 1024, swz = sb ^ (((sb >> 9) & 1) << 5); R = (st >> 1) * 16 + swz / 64; C = (st & 1) * 32 + (swz % 64) / 2; }
__host__ __device__ __forceinline__ int perm32(int rho) { const int n = rho >> 4, i = rho & 15; return 8 * (i >> 2) + 4 * n + (i & 3); }

struct Unit { int pm, pn; };
struct Gemm { const bf16_t* A; const bf16_t* Bt; int M, N, K; };

struct StaticOrder {
    int nM, nN, nwg, G, c;
    __host__ __device__ void init(int M, int N, int G_, int c_) { nM = M / BM; nN = N / BM; nwg = nM * nN; G = G_; c = c_; }
    __host__ __device__ bool next(int i, Unit& u) const {
        const long L = (long)i * G + c; if (L >= nwg) return false;
        int wgid = (int)L; { const int q = nwg / NXCD, r = nwg % NXCD, xcd = wgid % NXCD, off = wgid / NXCD; wgid = (xcd < r ? xcd * (q + 1) : r * (q + 1) + (xcd - r) * q) + off; }
        const int nig = WGM * nN, gid = wgid / nig, fm = gid * WGM, gsz = (nM - fm) < WGM ? (nM - fm) : WGM;
        u.pm = fm + ((wgid % nig) % gsz); u.pn = (wgid % nig) / gsz; return true;
    }
    __device__ __forceinline__ void a_ready(const Unit&) const {}
    __device__ __forceinline__ void done(const Unit&) const {}
};

__device__ __forceinline__ unsigned cvt_pk_bf16(float lo, float hi) { unsigned r; asm volatile("v_cvt_pk_bf16_f32 %0, %1, %2" : "=v"(r) : "v"(lo), "v"(hi)); return r; }

__device__ __forceinline__ float silu_mul(float g, float u) { return g * __builtin_amdgcn_rcpf(1.0f + __builtin_amdgcn_exp2f(-1.4426950408889634f * g)) * u; }

struct EpiSwiGLU {
    static constexpr bool PERM = true, AFTER_DRAIN = false;
    bf16_t* O;
    __device__ __forceinline__ void operator()(const f32x4 (&acc)[2][2][4][2], const Unit& u, int wr, int wc, int fr_, int fq_) const {
        int fr = fr_, fq = fq_; asm volatile("" : "+v"(fr), "+v"(fq));
        const int row0 = u.pm * BM + wr * 64 + fr, col0 = u.pn * HALF + wc * 32 + 8 * fq;
#pragma unroll
        for (int ai = 0; ai < 2; ++ai)
#pragma unroll
            for (int m = 0; m < 4; ++m) { bf16_t* rowp = O + (size_t)(row0 + ai * HALF + m * 16) * FF + col0;
                const f32x4 g0 = acc[ai][0][m][0], g1 = acc[ai][0][m][1], u0 = acc[ai][1][m][0], u1 = acc[ai][1][m][1];
                u32x4 w; w.x = cvt_pk_bf16(silu_mul(g0[0], u0[0]), silu_mul(g0[1], u0[1])); w.y = cvt_pk_bf16(silu_mul(g0[2], u0[2]), silu_mul(g0[3], u0[3]));
                w.z = cvt_pk_bf16(silu_mul(g1[0], u1[0]), silu_mul(g1[1], u1[1])); w.w = cvt_pk_bf16(silu_mul(g1[2], u1[2]), silu_mul(g1[3], u1[3]));
                *(u32x4*)rowp = w; }
    }
};
struct EpiRes {
    static constexpr bool PERM = false, AFTER_DRAIN = false;
    const float* xin_p; const float* xin_s; float* out; const float* gate; float coef;
    __device__ __forceinline__ void operator()(const f32x4 (&acc)[2][2][4][2], const Unit& u, int wr, int wc, int fr_, int fq_) const {
        int fr = fr_, fq = fq_; asm volatile("" : "+v"(fr), "+v"(fq));
        const int col0 = u.pn * BM + wc * 32 + 4 * fq;
        const bool prm = u.pm < MP / BM;
#pragma unroll
        for (int ai = 0; ai < 2; ++ai)
#pragma unroll
            for (int m = 0; m < 4; ++m) {
                const int rl = ai * HALF + wr * 64 + m * 16 + fr, row = u.pm * BM + rl;
                const int b = prm ? (u.pm >> 3) : NB_P + (rl >> 5);
                const float* xr = (prm ? xin_p + (size_t)row * D : xin_s + (size_t)(row - MP) * D) + col0;
                const float* gr = gate + (size_t)b * NMOD + col0;
                float* orow = out + (size_t)row * D + col0;
#pragma unroll
                for (int bj = 0; bj < 2; ++bj)
#pragma unroll
                    for (int n = 0; n < 2; ++n) { const f32x4 xv = *(const f32x4*)(xr + bj * HALF + n * 16), gv = *(const f32x4*)(gr + bj * HALF + n * 16);
                        *(f32x4*)(orow + bj * HALF + n * 16) = xv + (gv * coef) * acc[ai][bj][m][n]; }
                asm volatile("" ::: "memory"); }
    }
};
struct EpiWin {
    static constexpr bool PERM = true, AFTER_DRAIN = false;
    bf16_t* UV; bf16_t* GLU; bf16_t* GLUS; float* out_cp; float* out_cs;
    __device__ __forceinline__ void operator()(const f32x4 (&acc)[2][2][4][2], const Unit& u, int wr, int wc, int fr_, int fq_) const {
        int fr = fr_, fq = fq_; asm volatile("" : "+v"(fr), "+v"(fq));
        if (u.pn < 8) {
            const int row0 = u.pm * BM + wr * 64 + fr, col0 = u.pn * BM + wc * 32 + 8 * fq;
#pragma unroll
            for (int ai = 0; ai < 2; ++ai)
#pragma unroll
                for (int m = 0; m < 4; ++m) { bf16_t* rowp = UV + (size_t)(row0 + ai * HALF + m * 16) * 2048 + col0;
#pragma unroll
                    for (int bj = 0; bj < 2; ++bj) { const f32x4 v0 = acc[ai][bj][m][0], v1 = acc[ai][bj][m][1];
                        u32x4 w; w.x = cvt_pk_bf16(v0[0], v0[1]); w.y = cvt_pk_bf16(v0[2], v0[3]); w.z = cvt_pk_bf16(v1[0], v1[1]); w.w = cvt_pk_bf16(v1[2], v1[3]);
                        *(u32x4*)(rowp + bj * HALF) = w; } }
        } else {
            const int ch0 = (u.pn - 8) * HALF + wc * 32 + 8 * fq;
            const bool prm = u.pm < MP / BM;
#pragma unroll
            for (int ai = 0; ai < 2; ++ai)
#pragma unroll
                for (int m = 0; m < 4; ++m) {
                    const int rl = ai * HALF + wr * 64 + m * 16 + fr, row = u.pm * BM + rl;
                    const f32x4 a0 = acc[ai][0][m][0], a1 = acc[ai][0][m][1], b0 = acc[ai][1][m][0], b1 = acc[ai][1][m][1];
                    f32x4 g0, g1;
#pragma unroll
                    for (int j = 0; j < 4; ++j) { g0[j] = a0[j] * fsigmoid(b0[j]); g1[j] = a1[j] * fsigmoid(b1[j]); }
                    u32x4 w; w.x = cvt_pk_bf16(g0[0], g0[1]); w.y = cvt_pk_bf16(g0[2], g0[3]); w.z = cvt_pk_bf16(g1[0], g1[1]); w.w = cvt_pk_bf16(g1[2], g1[3]);
                    *(u32x4*)(prm ? GLU + (size_t)row * DB + ch0 : GLUS + ((size_t)(rl >> 5) * 62 + 30 + (rl & 31)) * DB + ch0) = w;
                    float* so = nullptr;
                    if (prm) { const int t = ((u.pm & 7) << 8) + rl; if (t >= SEQ - 30) so = out_cp + ((size_t)(u.pm >> 3) * 30 + (t - (SEQ - 30))) * DB + ch0; }
                    else { const int tl = rl & 31; if (tl >= 2) so = out_cs + ((size_t)(rl >> 5) * 30 + (tl - 2)) * DB + ch0; }
                    if (so) { *(f32x4*)so = g0; *(f32x4*)(so + 4) = g1; }
                }
        }
    }
};
template <class Epi, class Sched, bool ALIGN_EPI = false, bool SP2 = false>
__device__ __forceinline__ void gemm_phase(PG8_LAS unsigned char* lds, const Gemm g, const Sched& S, const Epi& E) {
    const int tid = fresh_tid(), wid = __builtin_amdgcn_readfirstlane(tid >> 6), lane = tid & 63, wr = wid >> 2, wc = wid & 3, fr = lane & 15, fq = lane >> 4;
    const int K = g.K, nt = K / BK;
    unsigned voffA[2], voffB[2];
#pragma unroll
    for (int i = 0; i < 2; ++i) { int R, C; stage_rc(tid * 16 + i * 8192, R, C); const int Rb = Epi::PERM ? ((R & ~31) + perm32(R & 31)) : R;
        voffA[i] = (unsigned)(R * K + C) * 2u; voffB[i] = (unsigned)(Rb * K + C) * 2u; }
    const size_t kstep = (size_t)(BK * 2);
    const size_t hstep = (size_t)HALF * K * 2;
    const size_t tstep = 2 * hstep;
    const unsigned ldsw = (unsigned)wid * 1024u;
    const int aoff = lds_byte(wr * 64 + fr, fq * 8), boff = lds_byte(wc * 32 + fr, fq * 8);
#define PG8_SA(b, h) (((b) * 2 + (h)) * HTB)
#define PG8_SB(b, h) ((4 + (b) * 2 + (h)) * HTB)
#define PG8_STAGE(bufoff, gbase, voff) do { _Pragma("unroll") for (int _i = 0; _i < 2; ++_i) \
        __builtin_amdgcn_global_load_lds((const unsigned*)((const char*)(gbase) + (voff)[_i]), (PG8_LAS unsigned*)(lds + (bufoff) + ldsw + _i * 8192), 16, 0, 0); } while (0)
#define PG8_LDA(dst, b, h) do { _Pragma("unroll") for (int m = 0; m < 4; ++m) _Pragma("unroll") for (int k = 0; k < 2; ++k) dst[m][k] = *(const PG8_LAS bf16x8*)(lds + PG8_SA(b, h) + aoff + m * 2048 + k * 1024); } while (0)
#define PG8_LDB(dst, b, h) do { _Pragma("unroll") for (int n = 0; n < 2; ++n) _Pragma("unroll") for (int k = 0; k < 2; ++k) dst[n][k] = *(const PG8_LAS bf16x8*)(lds + PG8_SB(b, h) + boff + n * 2048 + k * 1024); } while (0)
#define PG8_MMA(ai, bj, At, Bt) do { __builtin_amdgcn_s_setprio(1); _Pragma("unroll") for (int m = 0; m < 4; ++m) _Pragma("unroll") for (int n = 0; n < 2; ++n) _Pragma("unroll") for (int k = 0; k < 2; ++k) \
        acc[ai][bj][m][n] = __builtin_amdgcn_mfma_f32_16x16x32_bf16(Bt[n][k], At[m][k], acc[ai][bj][m][n], 0, 0, 0); __builtin_amdgcn_s_setprio(0); } while (0)
#define PG8_WAIT_V(n) asm volatile("s_waitcnt vmcnt(" #n ")" ::: "memory")
#define PG8_WAIT_L(n) asm volatile("s_waitcnt lgkmcnt(" #n ")" ::: "memory")
#define PG8_BAR __builtin_amdgcn_s_barrier()
#define PG8_SCHED __builtin_amdgcn_sched_barrier(0)
    Unit cur, nxt; int ui = 0;
    if (!S.next(0, cur)) return;
    f32x4 acc[2][2][4][2];
#pragma unroll
    for (int a = 0; a < 2; ++a)
#pragma unroll
        for (int b = 0; b < 2; ++b)
#pragma unroll
            for (int m = 0; m < 4; ++m)
#pragma unroll
                for (int n = 0; n < 2; ++n) acc[a][b][m][n] = (f32x4){0.f, 0.f, 0.f, 0.f};
    bf16x8 At[4][2], B0[2][2], B1[2][2];
    const char* cA = (const char*)g.A + (size_t)cur.pm * tstep; const char* cB = (const char*)g.Bt + (size_t)cur.pn * tstep;
    S.a_ready(cur);
    if constexpr (SP2) {
        PG8_STAGE(PG8_SB(0, 0), cB, voffB); PG8_STAGE(PG8_SB(0, 1), cB + hstep, voffB); PG8_STAGE(PG8_SA(0, 0), cA, voffA); PG8_STAGE(PG8_SA(0, 1), cA + hstep, voffA);
        if (wr == 1) PG8_BAR;
        PG8_WAIT_V(2); PG8_BAR;
        PG8_STAGE(PG8_SB(1, 0), cB + kstep, voffB); PG8_STAGE(PG8_SA(1, 0), cA + kstep, voffA); PG8_STAGE(PG8_SB(1, 1), cB + hstep + kstep, voffB);
        PG8_WAIT_V(6); PG8_BAR;
    } else {
        PG8_STAGE(PG8_SB(0, 0), cB, voffB); PG8_STAGE(PG8_SA(0, 0), cA, voffA); PG8_STAGE(PG8_SB(0, 1), cB + hstep, voffB); PG8_STAGE(PG8_SA(0, 1), cA + hstep, voffA);
        if (wr == 1) PG8_BAR;
        PG8_WAIT_V(4); PG8_BAR;
        PG8_STAGE(PG8_SB(1, 0), cB + kstep, voffB); PG8_STAGE(PG8_SA(1, 0), cA + kstep, voffA); PG8_STAGE(PG8_SB(1, 1), cB + hstep + kstep, voffB);
        PG8_WAIT_V(6); PG8_BAR;
    }
    for (;;) {
        const bool has_next = S.next(ui + 1, nxt);
        const char* nA = has_next ? (const char*)g.A + (size_t)nxt.pm * tstep : cA; const char* nB = has_next ? (const char*)g.Bt + (size_t)nxt.pn * tstep : cB;
        for (int t = 0; t < nt; t += 2) {
            const bool last = (t == nt - 2);
            const char* a1 = cA + (size_t)(t + 1) * kstep;
            const char* a2 = last ? nA : cA + (size_t)(t + 2) * kstep; const char* b2 = last ? nB : cB + (size_t)(t + 2) * kstep;
            const char* a3 = a2 + kstep; const char* b3 = b2 + kstep;
            if (last && has_next) S.a_ready(nxt);
            if constexpr (SP2) {
            PG8_LDB(B0, 0, 0); PG8_LDB(B1, 0, 1); PG8_SCHED; PG8_LDA(At, 0, 0); PG8_STAGE(PG8_SA(1, 1), a1 + hstep, voffA);
            PG8_WAIT_V(8); PG8_WAIT_L(0); PG8_BAR; PG8_MMA(0, 0, At, B0); PG8_MMA(0, 1, At, B1); PG8_BAR; PG8_SCHED;
            PG8_LDA(At, 0, 1); PG8_STAGE(PG8_SB(0, 0), b2, voffB); PG8_STAGE(PG8_SB(0, 1), b2 + hstep, voffB); PG8_STAGE(PG8_SA(0, 0), a2, voffA);
            PG8_WAIT_V(8); PG8_WAIT_L(0); PG8_BAR; PG8_MMA(1, 0, At, B0); PG8_MMA(1, 1, At, B1); PG8_BAR; PG8_SCHED;
            PG8_LDB(B0, 1, 0); PG8_LDB(B1, 1, 1); PG8_SCHED; PG8_LDA(At, 1, 0); PG8_STAGE(PG8_SA(0, 1), a2 + hstep, voffA);
            PG8_WAIT_V(8); PG8_WAIT_L(0); PG8_BAR; PG8_MMA(0, 0, At, B0); PG8_MMA(0, 1, At, B1); PG8_BAR; PG8_SCHED;
            PG8_LDA(At, 1, 1); PG8_STAGE(PG8_SB(1, 0), b3, voffB); PG8_STAGE(PG8_SB(1, 1), b3 + hstep, voffB); PG8_STAGE(PG8_SA(1, 0), a3, voffA);
            PG8_WAIT_V(8); PG8_WAIT_L(0); PG8_BAR; PG8_MMA(1, 0, At, B0); PG8_MMA(1, 1, At, B1); PG8_BAR; PG8_SCHED;
            } else {
            PG8_LDB(B0, 0, 0); PG8_SCHED; PG8_LDA(At, 0, 0); PG8_STAGE(PG8_SA(1, 1), a1 + hstep, voffA);
            PG8_WAIT_L(8); PG8_BAR; PG8_WAIT_L(0); PG8_MMA(0, 0, At, B0); PG8_BAR; PG8_SCHED;
            PG8_LDB(B1, 0, 1); PG8_STAGE(PG8_SB(0, 0), b2, voffB);
            PG8_BAR; PG8_WAIT_L(0); PG8_MMA(0, 1, At, B1); PG8_BAR;
            PG8_LDA(At, 0, 1); PG8_STAGE(PG8_SA(0, 0), a2, voffA);
            PG8_BAR; PG8_WAIT_L(0); PG8_MMA(1, 0, At, B0); PG8_BAR; PG8_SCHED;
            PG8_STAGE(PG8_SB(0, 1), b2 + hstep, voffB);
            PG8_WAIT_V(6); PG8_BAR; PG8_MMA(1, 1, At, B1); PG8_BAR;
            PG8_LDB(B0, 1, 0); PG8_SCHED; PG8_LDA(At, 1, 0); PG8_STAGE(PG8_SA(0, 1), a2 + hstep, voffA);
            PG8_WAIT_L(8); PG8_BAR; PG8_WAIT_L(0); PG8_MMA(0, 0, At, B0); PG8_BAR; PG8_SCHED;
            PG8_LDB(B1, 1, 1); PG8_STAGE(PG8_SB(1, 0), b3, voffB);
            PG8_BAR; PG8_WAIT_L(0); PG8_MMA(0, 1, At, B1); PG8_BAR;
            PG8_LDA(At, 1, 1); PG8_STAGE(PG8_SA(1, 0), a3, voffA);
            PG8_BAR; PG8_WAIT_L(0); PG8_MMA(1, 0, At, B0); PG8_BAR; PG8_SCHED;
            PG8_STAGE(PG8_SB(1, 1), b3 + hstep, voffB);
            PG8_WAIT_V(6); PG8_BAR; PG8_MMA(1, 1, At, B1); PG8_BAR;
            }
        }
        if constexpr (ALIGN_EPI) { if (wr == 0) PG8_BAR; }
        if constexpr (!Epi::AFTER_DRAIN) { E(acc, cur, wr, wc, fr, fq); S.done(cur); }
        if (!has_next) break;
#pragma unroll
        for (int a = 0; a < 2; ++a)
#pragma unroll
            for (int b = 0; b < 2; ++b)
#pragma unroll
                for (int m = 0; m < 4; ++m)
#pragma unroll
                    for (int n = 0; n < 2; ++n) acc[a][b][m][n] = (f32x4){0.f, 0.f, 0.f, 0.f};
        cur = nxt; cA = nA; cB = nB; ++ui;
        if constexpr (ALIGN_EPI) { if (wr == 1) PG8_BAR; }
    }
    PG8_WAIT_V(0);
    if constexpr (!ALIGN_EPI) { if (wr == 0) PG8_BAR; }
    PG8_BAR;
    if constexpr (Epi::AFTER_DRAIN) { E.fused(acc, cur, wr, wc, fr, fq, lds, wid, lane); S.done(cur); }
#undef PG8_SA
#undef PG8_SB
#undef PG8_STAGE
#undef PG8_LDA
#undef PG8_LDB
#undef PG8_MMA
#undef PG8_WAIT_V
#undef PG8_WAIT_L
#undef PG8_BAR
#undef PG8_SCHED
}
}

struct Args { const float* in[26]; float* out; unsigned char* ws; int ph_lo, ph_hi; };
constexpr int NPH = 12;
typedef short bf16x8 __attribute__((ext_vector_type(8)));

__device__ __forceinline__ void transpose_item(const float* W, int K, int N, bf16* WT, int k0, int n0s, int n0d, LAS float* scr, int lane) {
#pragma unroll 8
    for (int i = 0; i < 32; ++i) { const int kk = 2 * i + (lane >> 5); scr[kk * 33 + (lane & 31)] = W[(size_t)(k0 + kk) * N + n0s + (lane & 31)]; }
    asm volatile("s_waitcnt lgkmcnt(0)" ::: "memory");
    const int c = lane & 7;
#pragma unroll
    for (int j = 0; j < 4; ++j) { const int n = (lane >> 3) + 8 * j; const LAS float* s = scr + (8 * c) * 33 + n;
        u32x4 o; o.x = pk2(s[0 * 33], s[1 * 33]); o.y = pk2(s[2 * 33], s[3 * 33]); o.z = pk2(s[4 * 33], s[5 * 33]); o.w = pk2(s[6 * 33], s[7 * 33]);
        *(u32x4*)(WT + (size_t)(n0d + n) * K + k0 + 8 * c) = o; }
    asm volatile("s_waitcnt lgkmcnt(0)" ::: "memory");
}
__device__ __forceinline__ int map_up(int n) { const int pn = n >> 8, s = (n >> 7) & 1, j = n & 127; return s * FF + 128 * pn + j; }
__device__ __forceinline__ int map_win(int n) { if (n < 2048) return n; const int t = n - 2048, q = t >> 8, s = (t >> 7) & 1, j = t & 127; return 2048 + 1024 * s + 128 * q + j; }

__device__ __forceinline__ void mod_item(const Args& a, LAS unsigned char* lds, int cb, int tid, int wave, int lane) {
    const float* cp = a.in[3]; const float* cs = a.in[4]; const float* w_ada = a.in[5]; const float* b_ada = a.in[6];
    float* mod = (float*)(a.ws + WS_MOD);
    LAS float* sl = (LAS float*)lds;
    f32x2 acc[NBT];
#pragma unroll
    for (int b = 0; b < NBT; ++b) acc[b] = (f32x2){0.f, 0.f};
    for (int kc = 0; kc < D; kc += 512) {
#pragma unroll
        for (int b = 0; b < NBT; ++b) { const float c = b < NB_P ? cp[b * D + kc + tid] : cs[(b - NB_P) * D + kc + tid]; sl[tid * NBT + b] = c * fsigmoid(c); }
        __syncthreads();
        const float* wp = w_ada + (size_t)(kc + 64 * wave) * NMOD + 128 * cb + 2 * lane;
#pragma unroll 4
        for (int kk = 0; kk < 64; ++kk) {
            const f32x2 wv = *(const f32x2*)(wp + (size_t)kk * NMOD);
            const LAS f32x4* sp = (const LAS f32x4*)(sl + (64 * wave + kk) * NBT);
#pragma unroll
            for (int q = 0; q < NBT / 4; ++q) { const f32x4 s4 = sp[q]; acc[4 * q + 0] += s4[0] * wv; acc[4 * q + 1] += s4[1] * wv; acc[4 * q + 2] += s4[2] * wv; acc[4 * q + 3] += s4[3] * wv; }
        }
        __syncthreads();
    }
    LAS float* red = (LAS float*)lds;
#pragma unroll
    for (int b = 0; b < NBT; ++b) *(LAS f32x2*)(red + (wave * NBT + b) * 128 + 2 * lane) = acc[b];
    __syncthreads();
#pragma unroll
    for (int i = 0; i < 6; ++i) { const int o = tid + 512 * i, b = o >> 7, col = o & 127; float s = b_ada[128 * cb + col];
#pragma unroll
        for (int w = 0; w < 8; ++w) s += red[(w * NBT + b) * 128 + col];
        mod[(size_t)b * NMOD + 128 * cb + col] = s; }
    __syncthreads();
}

__device__ __forceinline__ void p0_prologue(const Args& a, LAS unsigned char* lds, int G, int bid, int tid, int wave, int lane) {
    for (int cb = bid; cb < NMOD / 128; cb += G) mod_item(a, lds, cb, tid, wave, lane);
    { const float* w_s = a.in[13]; bf16* wsm = (bf16*)(a.ws + WS_WSM);
      for (int i = bid * 512 + tid; i < NG * 128 * 128; i += G * 512) { const int ii = (i >> 7) & 127, jj = i & 127; wsm[i] = (bf16)(jj <= ii ? f2bf(w_s[i]) : 0u); } }
    { const float* cache = a.in[2]; bf16* gs = (bf16*)(a.ws + WS_GLUS);
      for (int i = bid * 512 + tid; i < NB_S * 30 * DB; i += G * 512) { const int bs = i / (30 * DB), rem = i - bs * 30 * DB; gs[(size_t)bs * 62 * DB + rem] = (bf16)f2bf(cache[i]); } }
    LAS float* scr = (LAS float*)(lds + wave * 16384);
    const int gw = bid * 8 + wave, NGW = G * 8;
    constexpr int I_UP = (D / 64) * (2 * FF / 32), I_DN = (FF / 64) * (D / 32), I_IN = (D / 64) * (4096 / 32), I_OUT = (D / 64) * (D / 32);
    constexpr int NITEMS = 2 * I_UP + 2 * I_DN + I_IN + I_OUT;
    for (int it = gw; it < NITEMS; it += NGW) {
        int r = it;
        if (r < 2 * I_UP) { const int which = r >= I_UP; r -= which * I_UP; const int nblk = 2 * FF / 32, kb = r / nblk, nb = r % nblk;
            transpose_item(a.in[which ? 23 : 8], D, 2 * FF, (bf16*)(a.ws + (which ? WS_WUP2 : WS_WUP1)), 64 * kb, map_up(32 * nb), 32 * nb, scr, lane); continue; }
        r -= 2 * I_UP;
        if (r < 2 * I_DN) { const int which = r >= I_DN; r -= which * I_DN; const int nblk = D / 32, kb = r / nblk, nb = r % nblk;
            transpose_item(a.in[which ? 24 : 9], FF, D, (bf16*)(a.ws + (which ? WS_WDN2 : WS_WDN1)), 64 * kb, 32 * nb, 32 * nb, scr, lane); continue; }
        r -= 2 * I_DN;
        if (r < I_IN) { const int nblk = 4096 / 32, kb = r / nblk, nb = r % nblk;
            transpose_item(a.in[11], D, 4096, (bf16*)(a.ws + WS_WIN), 64 * kb, map_win(32 * nb), 32 * nb, scr, lane); continue; }
        r -= I_IN;
        { const int nblk = D / 32, kb = r / nblk, nb = r % nblk; transpose_item(a.in[21], D, D, (bf16*)(a.ws + WS_WOUT), 64 * kb, 32 * nb, 32 * nb, scr, lane); }
    }
}

template <bool FINAL>
__device__ __forceinline__ void norm_phase(const float* srcp, const float* srcs, const float* g, const float* mod, int sh_off, int sc_off, void* dst, int gw, int ngw, int lane) {
    for (int it = gw; it < M / 8; it += ngw) {
        const int row0 = it * 8, b = row_batch(row0);
        const float* src = row0 < MP ? srcp + (size_t)row0 * D : srcs + (size_t)(row0 - MP) * D;
        f32x4 Gv[8], Sv[8];
#pragma unroll
        for (int j = 0; j < 8; ++j) { const int col = 4 * lane + 256 * j; const f32x4 gg = *(const f32x4*)(g + col);
            if (FINAL) { Gv[j] = gg; Sv[j] = (f32x4){0.f, 0.f, 0.f, 0.f}; }
            else { const f32x4 sc = *(const f32x4*)(mod + (size_t)b * NMOD + sc_off + col); Gv[j] = gg * (1.0f + sc); Sv[j] = *(const f32x4*)(mod + (size_t)b * NMOD + sh_off + col); } }
        for (int r = 0; r < 8; ++r) {
            const f32x4* xr = (const f32x4*)(src + (size_t)r * D) + lane;
            f32x4 v[8]; float ss = 0.f;
#pragma unroll
            for (int j = 0; j < 8; ++j) { v[j] = xr[64 * j]; ss += (v[j][0] * v[j][0] + v[j][1] * v[j][1]) + (v[j][2] * v[j][2] + v[j][3] * v[j][3]); }
            const float rs = 1.0f / sqrtf(wave_sum(ss) * (1.0f / D) + EPS);
            if (FINAL) { f32x4* o = (f32x4*)((float*)dst + (size_t)(row0 + r) * D) + lane;
#pragma unroll
                for (int j = 0; j < 8; ++j) o[64 * j] = (v[j] * rs) * Gv[j]; }
            else { u32x2* o = (u32x2*)((bf16*)dst + (size_t)(row0 + r) * D) + lane;
#pragma unroll
                for (int j = 0; j < 8; ++j) { const f32x4 y = (v[j] * rs) * Gv[j] + Sv[j]; u32x2 w; w.x = pk2(y[0], y[1]); w.y = pk2(y[2], y[3]); o[64 * j] = w; } }
        }
    }
}

constexpr int MX_VS = 0, MX_RJ = 65536, MX_PART = 65536 + 256, MX_RED = 65536 + 2048, MX_STAT = 65536 + 8192;
__device__ __forceinline__ void mixer_unit(const Args& a, LAS unsigned char* lds, int rowbase, int chunkrow0, int ib, int sbs, int pos0, int tid_, int wave, int lane_) {
    int tid = tid_, lane = lane_; asm volatile("" : "+v"(tid), "+v"(lane));
    const bf16* UV = (const bf16*)(a.ws + WS_UV); const bf16* GLU = (const bf16*)(a.ws + WS_GLU); const bf16* WSM = (const bf16*)(a.ws + WS_WSM);
    bf16* YC = (bf16*)(a.ws + WS_H);
    const float* g_v = a.in[12]; const float* b_s = a.in[14]; const float* w_dw = a.in[15]; const float* b_dw = a.in[16]; const float* g_cn = a.in[17]; const float* b_cn = a.in[18];
    const float* g_oa = a.in[19]; const float* g_ob = a.in[20];
    LAS bf16* vs = (LAS bf16*)(lds + MX_VS); LAS float* rj = (LAS float*)(lds + MX_RJ); LAS float* part = (LAS float*)(lds + MX_PART);
    LAS float* red = (LAS float*)(lds + MX_RED); LAS float* stat = (LAS float*)(lds + MX_STAT);
    const int fr = lane & 15, fq = lane >> 4, g = wave;
#ifndef NO_MXA
    f32x4 acc[2][8];
#pragma unroll
    for (int mt = 0; mt < 2; ++mt)
#pragma unroll
        for (int nt = 0; nt < 8; ++nt) acc[mt][nt] = (f32x4){0.f, 0.f, 0.f, 0.f};
    for (int ks = 0; ks <= ib; ++ks) {
        __syncthreads();
        asm volatile("" : "+v"(tid));
#pragma unroll
        for (int i = 0; i < 8; ++i) { const int idx = tid + 512 * i, r = idx >> 7, ch = idx & 127;
            const u32x4 val = *(const u32x4*)(UV + (size_t)(chunkrow0 + 32 * ks + r) * 2048 + 1024 + 8 * ch);
            *(LAS u32x4*)(vs + r * 1024 + ((8 * ch) ^ (((r >> 3) & 3) << 4))) = val; }
        __syncthreads();
#pragma unroll
        for (int rr = 0; rr < 4; ++rr) { const int r = 4 * wave + rr; const LAS u32x4* p = (const LAS u32x4*)(vs + r * 1024 + lane * 16); float ss = 0.f;
#pragma unroll
            for (int h = 0; h < 2; ++h) { const u32x4 q = p[h];
#pragma unroll
                for (int e = 0; e < 4; ++e) { const float lo = bflo(q[e]), hi = bfhi(q[e]); ss += lo * lo + hi * hi; } }
            ss = wave_sum(ss); if (lane == 0) rj[r] = 1.0f / sqrtf(ss * (1.0f / DA) + EPS); }
        __syncthreads();
        if (sbs >= 0) {
            float* ov = a.out + OUT_VS + (size_t)sbs * SSEQ * DA;
#pragma unroll
            for (int i = 0; i < 8; ++i) { const int idx = tid + 512 * i, r = idx >> 7, ch = idx & 127;
                const u32x4 q = *(const LAS u32x4*)(vs + r * 1024 + ((8 * ch) ^ (((r >> 3) & 3) << 4))); const float rr = rj[r];
                const f32x4 g0 = *(const f32x4*)(g_v + 8 * ch), g1 = *(const f32x4*)(g_v + 8 * ch + 4);
                f32x4 o0, o1; o0[0] = bflo(q[0]) * rr * g0[0]; o0[1] = bfhi(q[0]) * rr * g0[1]; o0[2] = bflo(q[1]) * rr * g0[2]; o0[3] = bfhi(q[1]) * rr * g0[3];
                o1[0] = bflo(q[2]) * rr * g1[0]; o1[1] = bfhi(q[2]) * rr * g1[1]; o1[2] = bflo(q[3]) * rr * g1[2]; o1[3] = bfhi(q[3]) * rr * g1[3];
                *(f32x4*)(ov + (size_t)r * DA + 8 * ch) = o0; *(f32x4*)(ov + (size_t)r * DA + 8 * ch + 4) = o1; }
        }
        float rjv[8];
#pragma unroll
        for (int jj = 0; jj < 8; ++jj) rjv[jj] = rj[8 * fq + jj];
        bf16x8 af[2];
#pragma unroll
        for (int mt = 0; mt < 2; ++mt) af[mt] = *(const bf16x8*)(WSM + ((size_t)(g * 128 + 32 * ib + 16 * mt + fr)) * 128 + 32 * ks + 8 * fq);
#pragma unroll
        for (int nt = 0; nt < 8; ++nt) { const int d = g * HD + 16 * nt + fr; const float gvd = g_v[d];
            float f[8];
#pragma unroll
            for (int jj = 0; jj < 8; ++jj) { const unsigned x = vs[(8 * fq + jj) * 1024 + (d ^ (fq << 4))]; f[jj] = __builtin_bit_cast(float, x << 16) * rjv[jj] * gvd; }
            u32x4 bw; bw.x = pk2(f[0], f[1]); bw.y = pk2(f[2], f[3]); bw.z = pk2(f[4], f[5]); bw.w = pk2(f[6], f[7]);
            const bf16x8 bfrag = __builtin_bit_cast(bf16x8, bw);
#pragma unroll
            for (int mt = 0; mt < 2; ++mt) acc[mt][nt] = __builtin_amdgcn_mfma_f32_16x16x32_bf16(bfrag, af[mt], acc[mt][nt], 0, 0, 0);
            if (nt & 1) asm volatile("" ::: "memory"); }
    }
    {
        float ss[2];
#pragma unroll
        for (int mt = 0; mt < 2; ++mt) { const float bias = b_s[g * 128 + 32 * ib + 16 * mt + fr]; const int row = rowbase + 16 * mt + fr; float s = 0.f;
#pragma unroll
            for (int nt = 0; nt < 8; ++nt) { const u32x2 uw = *(const u32x2*)(UV + (size_t)row * 2048 + g * HD + 16 * nt + 4 * fq);
                f32x4 y = acc[mt][nt] + bias; y[0] *= bflo(uw.x); y[1] *= bfhi(uw.x); y[2] *= bflo(uw.y); y[3] *= bfhi(uw.y);
                acc[mt][nt] = y; s += (y[0] * y[0] + y[1] * y[1]) + (y[2] * y[2] + y[3] * y[3]); }
            s += __shfl_xor(s, 16); s += __shfl_xor(s, 32); ss[mt] = s;
            if (fq == 0) part[g * 32 + 16 * mt + fr] = s; }
        __syncthreads();
#pragma unroll
        for (int mt = 0; mt < 2; ++mt) { float tot = 0.f;
#pragma unroll
            for (int w = 0; w < 8; ++w) tot += part[w * 32 + 16 * mt + fr];
            const float ra = 1.0f / sqrtf(tot * (1.0f / DA) + EPS); const int row = rowbase + 16 * mt + fr;
#pragma unroll
            for (int nt = 0; nt < 8; ++nt) { const int d = g * HD + 16 * nt + 4 * fq; const f32x4 go = *(const f32x4*)(g_oa + d); const f32x4 o = (acc[mt][nt] * ra) * go;
                u32x2 w; w.x = pk2(o[0], o[1]); w.y = pk2(o[2], o[3]); *(u32x2*)(YC + (size_t)row * 2048 + d) = w; } }
    }
#endif
#ifndef NO_MXB
    {
        int c = 2 * tid; asm volatile("" : "+v"(c) :: "memory");
        f32x2 wk[CW];
#pragma unroll
        for (int k = 0; k < CW; ++k) wk[k] = *(const f32x2*)(w_dw + k * DB + c);
        const f32x2 bd = *(const f32x2*)(b_dw + c), gc = *(const f32x2*)(g_cn + c), bc = *(const f32x2*)(b_cn + c), gb = *(const f32x2*)(g_ob + c);
        const bool zero_hist = sbs < 0 && pos0 == 0;
        const bf16* xbase = (sbs >= 0 ? (const bf16*)(a.ws + WS_GLUS) + ((size_t)sbs * 62 + 30) * DB : GLU + (size_t)rowbase * DB) + c;
#pragma unroll 1
        for (int h = 0; h < 2; ++h) {
            const int tb = 16 * h;
            f32x2 y[16];
#pragma unroll
            for (int t = 0; t < 16; ++t) y[t] = bd;
            const bf16* xp = xbase + (ptrdiff_t)(tb - 30) * DB;
#pragma unroll
            for (int si = 0; si < 46; ++si) {
                const int s = tb - 30 + si;
                const unsigned w = *(const unsigned*)xp; xp += DB; asm volatile("" : "+v"(xp));
                f32x2 x = (f32x2){bflo(w), bfhi(w)};
                if (s < 0 && zero_hist) x = (f32x2){0.f, 0.f};
#pragma unroll
                for (int tt = (si > 30 ? si - 30 : 0); tt <= (si < 15 ? si : 15); ++tt) y[tt] += wk[si - tt] * x;
                if ((si & 7) == 7) asm volatile("" ::: "memory");
            }
#pragma unroll
            for (int t = 0; t < 16; ++t) { float s1 = y[t][0] + y[t][1], s2 = y[t][0] * y[t][0] + y[t][1] * y[t][1]; s1 = wave_sum(s1); s2 = wave_sum(s2);
                if (lane == 0) { red[wave * 32 + t] = s1; red[wave * 32 + 16 + t] = s2; } }
            __syncthreads();
            if (tid < 32) { float s = 0.f;
#pragma unroll
                for (int w = 0; w < 8; ++w) s += red[w * 32 + tid];
                stat[tid] = s; }
            __syncthreads();
#pragma unroll
            for (int t = 0; t < 16; ++t) { const float mean = stat[t] * (1.0f / DB), var = stat[16 + t] * (1.0f / DB) - mean * mean, rstd = 1.0f / sqrtf(var + EPS);
                f32x2 z = ((y[t] - mean) * rstd) * gc + bc; z[0] *= fsigmoid(z[0]); z[1] *= fsigmoid(z[1]); y[t] = z;
                float q = z[0] * z[0] + z[1] * z[1]; q = wave_sum(q); if (lane == 0) red[256 + wave * 16 + t] = q; }
            __syncthreads();
            if (tid < 16) { float s = 0.f;
#pragma unroll
                for (int w = 0; w < 8; ++w) s += red[256 + w * 16 + tid];
                stat[32 + tid] = s; }
            __syncthreads();
#pragma unroll
            for (int t = 0; t < 16; ++t) { const float rb = 1.0f / sqrtf(stat[32 + t] * (1.0f / DB) + EPS); const f32x2 o = (y[t] * rb) * gb;
                *(unsigned*)(YC + (size_t)(rowbase + tb + t) * 2048 + DA + c) = pk2(o[0], o[1]); }
        }
    }
#endif
}
__device__ __forceinline__ void mixer_phase(const Args& a, LAS unsigned char* lds, int G, int bid, int tid, int wave, int lane) {
    for (int idx = bid; idx < 1024 + NB_S; idx += G) {
        if (idx < 1024) { const int r = idx >> 8, w = idx & 255, cc = (w >> 2) + 64 * r, ib = ((w & 3) + r) & 3, b = cc >> 4, ck = cc & 15;
            const int chunkrow0 = b * SEQ + ck * 128; mixer_unit(a, lds, chunkrow0 + 32 * ib, chunkrow0, ib, -1, ck * 128 + 32 * ib, tid, wave, lane); }
        else { const int bs = idx - 1024, row0 = MP + 32 * bs; mixer_unit(a, lds, row0, row0, 0, bs, 0, tid, wave, lane); }
    }
}

__global__ void __launch_bounds__(512, 2) mega_fwd(Args a) {
    extern __shared__ __attribute__((aligned(16))) unsigned char lds_raw[];
    LAS unsigned char* lds = (LAS unsigned char*)lds_raw;
    const int G = gridDim.x, bid = blockIdx.x;
#define TIDS const int tid = fresh_tid(), lane = tid & 63, wave = __builtin_amdgcn_readfirstlane(tid >> 6), gw = bid * 8 + wave, ngw = G * 8; (void)gw; (void)ngw; (void)lane
    const int lo = a.ph_lo, hi = a.ph_hi;
    unsigned char* ws = a.ws;
    float* mod = (float*)(ws + WS_MOD);
    bf16* Hb = (bf16*)(ws + WS_H); bf16* ACT = (bf16*)(ws + WS_ACT);
    float* X = a.out;
#ifndef PHMASK
#define PHMASK 0xFFF
#endif
#define IN(k) (((PHMASK >> (k)) & 1) && lo <= (k) && (k) < hi)
#define SEAM(k) do { if (IN(k) && IN((k) + 1)) cg::this_grid().sync(); } while (0)

    if (IN(0)) { TIDS; p0_prologue(a, lds, G, bid, tid, wave, lane); }
    SEAM(0);
    if (IN(1)) { TIDS; norm_phase<false>(a.in[0], a.in[1], a.in[7], mod, OFF_SH1, OFF_SC1, Hb, gw, ngw, lane); }
    SEAM(1);
    if (IN(2)) { pg8::Gemm g{Hb, (const bf16*)(ws + WS_WUP1), M, 2 * FF, D}; pg8::StaticOrder S; S.init(M, 2 * FF, G, bid); pg8::EpiSwiGLU E{ACT};
        pg8::gemm_phase<pg8::EpiSwiGLU, pg8::StaticOrder, true, true>(lds, g, S, E); }
    SEAM(2);
    if (IN(3)) { pg8::Gemm g{ACT, (const bf16*)(ws + WS_WDN1), M, D, FF}; pg8::StaticOrder S; S.init(M, D, G, bid); pg8::EpiRes E{a.in[0], a.in[1], X, mod + OFF_GT1, 0.5f};
        pg8::gemm_phase<pg8::EpiRes, pg8::StaticOrder, true, true>(lds, g, S, E); }
    SEAM(3);
    if (IN(4)) { TIDS; norm_phase<false>(X, X + (size_t)MP * D, a.in[10], mod, OFF_SH2, OFF_SC2, Hb, gw, ngw, lane); }
    SEAM(4);
    if (IN(5)) { pg8::Gemm g{Hb, (const bf16*)(ws + WS_WIN), M, 4096, D}; pg8::StaticOrder S; S.init(M, 4096, G, bid);
        pg8::EpiWin E{(bf16*)(ws + WS_UV), (bf16*)(ws + WS_GLU), (bf16*)(ws + WS_GLUS), a.out + OUT_CP, a.out + OUT_CS};
        pg8::gemm_phase<pg8::EpiWin, pg8::StaticOrder, true, true>(lds, g, S, E); }
    SEAM(5);
    if (IN(6)) { TIDS; mixer_phase(a, lds, G, bid, tid, wave, lane); }
    SEAM(6);
    if (IN(7)) { pg8::Gemm g{Hb, (const bf16*)(ws + WS_WOUT), M, D, D}; pg8::StaticOrder S; S.init(M, D, G, bid); pg8::EpiRes E{X, X + (size_t)MP * D, X, mod + OFF_GT2, 1.0f};
        pg8::gemm_phase<pg8::EpiRes, pg8::StaticOrder, true, true>(lds, g, S, E); }
    SEAM(7);
    if (IN(8)) { TIDS; norm_phase<false>(X, X + (size_t)MP * D, a.in[22], mod, OFF_SH3, OFF_SC3, Hb, gw, ngw, lane); }
    SEAM(8);
    if (IN(9)) { pg8::Gemm g{Hb, (const bf16*)(ws + WS_WUP2), M, 2 * FF, D}; pg8::StaticOrder S; S.init(M, 2 * FF, G, bid); pg8::EpiSwiGLU E{ACT};
        pg8::gemm_phase<pg8::EpiSwiGLU, pg8::StaticOrder, true, true>(lds, g, S, E); }
    SEAM(9);
    if (IN(10)) { pg8::Gemm g{ACT, (const bf16*)(ws + WS_WDN2), M, D, FF}; pg8::StaticOrder S; S.init(M, D, G, bid); pg8::EpiRes E{X, X + (size_t)MP * D, X, mod + OFF_GT3, 0.5f};
        pg8::gemm_phase<pg8::EpiRes, pg8::StaticOrder, true, true>(lds, g, S, E); }
    SEAM(10);
    if (IN(11)) { TIDS; norm_phase<true>(X, X + (size_t)MP * D, a.in[25], mod, 0, 0, X, gw, ngw, lane); }
#undef IN
#undef SEAM
}

extern "C" void kernel_launch(void* const* d_in, const int* in_sizes, int n_in, void* d_out, int out_size, void* d_ws, size_t ws_size, hipStream_t stream) {
    static int grid = 0;
    if (grid == 0) {
        if (n_in != 26 || in_sizes[0] != MP * D || (size_t)out_size != OUT_END || ws_size < WS_END) {
            fprintf(stderr, "kernel_launch: unexpected shapes (n_in %d, in0 %d, out %d, ws %zu); nothing launched\n", n_in, n_in > 0 ? in_sizes[0] : -1, out_size, ws_size); grid = -1; return; }
        int dev = 0, cus = 0, per_cu = 0;
        if (hipGetDevice(&dev) != hipSuccess || hipDeviceGetAttribute(&cus, hipDeviceAttributeMultiprocessorCount, dev) != hipSuccess) { grid = -1; return; }
        if (hipFuncSetAttribute((const void*)mega_fwd, hipFuncAttributeMaxDynamicSharedMemorySize, LDS_BYTES) != hipSuccess) { fprintf(stderr, "kernel_launch: hipFuncSetAttribute failed\n"); grid = -1; return; }
        if (hipOccupancyMaxActiveBlocksPerMultiprocessor(&per_cu, (const void*)mega_fwd, 512, LDS_BYTES) != hipSuccess || per_cu < 1) { fprintf(stderr, "kernel_launch: occupancy query says %d\n", per_cu); per_cu = 1; }
        (void)hipGetLastError();
        grid = cus * per_cu;
    }
    if (grid < 0) return;
    Args a{};
    for (int i = 0; i < 26; ++i) a.in[i] = (const float*)d_in[i];
    a.out = (float*)d_out; a.ws = (unsigned char*)d_ws;
#if MK_PER_PHASE
    for (int ph = 0; ph < NPH; ++ph) { a.ph_lo = ph; a.ph_hi = ph + 1; hipLaunchKernelGGL(mega_fwd, dim3(grid), dim3(512), LDS_BYTES, stream, a); }
#else
    a.ph_lo = 0; a.ph_hi = NPH;
    void* args[] = {&a};
    hipError_t e = hipLaunchCooperativeKernel((const void*)mega_fwd, dim3(grid), dim3(512), args, LDS_BYTES, stream);
    if (e != hipSuccess) fprintf(stderr, "kernel_launch: cooperative launch failed: %s (grid %d)\n", hipGetErrorString(e), grid);
#endif
}
```

```cpp
#include <hip/hip_runtime.h>
#include <hip/hip_cooperative_groups.h>
#include <cstdio>
#include <cstdint>
namespace cg = cooperative_groups;

#ifndef MK_PER_PHASE
#define MK_PER_PHASE 0
#endif

constexpr int D = 2048, NB_P = 16, SEQ = 2048, NB_S = 8, SSEQ = 32;
constexpr int MP = NB_P * SEQ, MS = NB_S * SSEQ, M = MP + MS;
constexpr int DA = 1024, DB = 1024, NG = 8, HD = 128, FF = 5632, NMOD = 9 * D, CW = 31, NBT = NB_P + NB_S;
constexpr float EPS = 1e-6f;
constexpr int OFF_SH1 = 0, OFF_SC1 = D, OFF_GT1 = 2 * D, OFF_SH2 = 3 * D, OFF_SC2 = 4 * D, OFF_GT2 = 5 * D, OFF_SH3 = 6 * D, OFF_SC3 = 7 * D, OFF_GT3 = 8 * D;
constexpr size_t OUT_Y = 0, OUT_CP = (size_t)M * D, OUT_CS = OUT_CP + (size_t)NB_P * 30 * DB, OUT_VS = OUT_CS + (size_t)NB_S * 30 * DB, OUT_END = OUT_VS + (size_t)NB_S * SSEQ * DA;
constexpr size_t MiB = 1u << 20;
constexpr size_t WS_MOD = 0, WS_CTL = 1835008  , CTL_BYTES = 65536, WS_WSM = 2 * MiB, WS_GLUS = 3 * MiB  , WS_WUP1 = 4 * MiB, WS_WDN1 = 48 * MiB, WS_WIN = 70 * MiB, WS_WOUT = 86 * MiB, WS_WUP2 = 94 * MiB, WS_WDN2 = 138 * MiB;
constexpr size_t WS_H = 160 * MiB, WS_ACT = 289 * MiB, WS_UV = WS_ACT, WS_GLU = WS_ACT + 129 * MiB, WS_PART = 644 * MiB  , WS_RS = 690 * MiB  , WS_X16 = 700 * MiB  , WS_END = 830 * MiB;
static_assert(((D / 64) * (2 * FF / 64) * 2 + (FF / 64) * (D / 64) * 2 + (D / 64) * (4096 / 64) + (D / 64) * (D / 64)) % 4 == 0, "prologue items per claim");
static_assert((size_t)M * D * 2 <= 129 * MiB && (size_t)M * FF * 2 <= (644 - 289) * MiB, "ws map");
constexpr int LDS_BYTES = 147456;

#define LAS __attribute__((address_space(3)))
typedef unsigned short bf16;
typedef float f32x4 __attribute__((ext_vector_type(4)));
typedef float f32x2 __attribute__((ext_vector_type(2)));
typedef unsigned u32x4 __attribute__((ext_vector_type(4)));
typedef unsigned u32x2 __attribute__((ext_vector_type(2)));

__device__ __forceinline__ unsigned f2bf(float f) { unsigned u = __builtin_bit_cast(unsigned, f); return (u + 0x7fffu + ((u >> 16) & 1u)) >> 16; }
__device__ __forceinline__ unsigned pk2(float lo, float hi) { return f2bf(lo) | (f2bf(hi) << 16); }
__device__ __forceinline__ float bflo(unsigned w) { return __builtin_bit_cast(float, w << 16); }
__device__ __forceinline__ float bfhi(unsigned w) { return __builtin_bit_cast(float, w & 0xffff0000u); }
__device__ __forceinline__ float fsigmoid(float x) { return __builtin_amdgcn_rcpf(1.0f + __builtin_amdgcn_exp2f(-1.4426950408889634f * x)); }
__device__ __forceinline__ float wave_sum(float v) {
#pragma unroll
    for (int o = 1; o < 64; o <<= 1) v += __shfl_xor(v, o);
    return v;
}
__device__ __forceinline__ int fresh_tid() { int t = threadIdx.x; asm volatile("" : "+v"(t)); return t; }
__device__ __forceinline__ int row_batch(int row) { return row < MP ? (row >> 11) : NB_P + ((row - MP) >> 5); }

namespace pg8 {
#define PG8_LAS __attribute__((address_space(3)))
typedef unsigned short bf16_t;
typedef short bf16x8 __attribute__((ext_vector_type(8)));
typedef float f32x4 __attribute__((ext_vector_type(4)));
typedef unsigned u32x4 __attribute__((ext_vector_type(4)));
typedef unsigned u32x2 __attribute__((ext_vector_type(2)));
constexpr int BM = 256, BK = 64, HALF = 128, HTB = HALF * BK * 2  , STAGE_BYTES = 8 * HTB, NXCD = 8, WGM = 8;

__host__ __device__ __forceinline__ int lds_byte(int r, int c) { const int st = (r >> 4) * 2 + (c >> 5), rr = r & 15, cc = c & 31, ob = rr * 64 + cc * 2; return st * 1024 + (ob ^ (((ob >> 9) & 1) << 5)); }
__host__ __device__ __forceinline__ void stage_rc(int b, int& R, int& C) { const int st = b / 1024, sb = b % 1024, swz = sb ^ (((sb >> 9) & 1) << 5); R = (st >> 1) * 16 + swz / 64; C = (st & 1) * 32 + (swz % 64) / 2; }
__host__ __device__ __forceinline__ int perm32(int rho) { const int n = rho >> 4, i = rho & 15; return 8 * (i >> 2) + 4 * n + (i & 3); }

struct Unit { int pm, pn, kt0, nkt, slice, nsplit; };
struct Gemm { const bf16_t* A; const bf16_t* Bt; int M, N, K; };

struct StaticOrder {
    int nM, nN, nwg, G, c;
    __host__ __device__ void init(int M, int N, int G_, int c_) { nM = M / BM; nN = N / BM; nwg = nM * nN; G = G_; c = c_; }
    __host__ __device__ bool next(int i, Unit& u) const {
        const long L = (long)i * G + c; if (L >= nwg) return false;
        int wgid = (int)L; { const int q = nwg / NXCD, r = nwg % NXCD, xcd = wgid % NXCD, off = wgid / NXCD; wgid = (xcd < r ? xcd * (q + 1) : r * (q + 1) + (xcd - r) * q) + off; }
        const int nig = WGM * nN, gid = wgid / nig, fm = gid * WGM, gsz = (nM - fm) < WGM ? (nM - fm) : WGM;
        u.pm = fm + ((wgid % nig) % gsz); u.pn = (wgid % nig) / gsz; return true;
    }
    __device__ __forceinline__ void a_ready(const Unit&) const {}
    __device__ __forceinline__ void done(const Unit&) const {}
};

struct MixedOrder {
    int nMp, nN, nwgp, G, c, nsplit, nkt, nks, wgm, rev = 0;
    __host__ __device__ void init(int Mp, int N, int K, int nsplit_, int G_, int c_, int wgm_ = WGM, int bk = BK) { wgm = wgm_; nMp = Mp / BM; nN = N / BM; nwgp = nMp * nN; G = G_; c = c_; nsplit = nsplit_; nkt = K / bk; nks = nkt / nsplit_; }
    __host__ __device__ bool next(int i, Unit& u) const {
        const long L = (long)i * G + c; const bool smp = L >= nwgp; const int j = (int)(L - nwgp);
        if (smp && j >= nN * nsplit) return false;
        int wgid = smp ? 0 : (int)L; { const int q = nwgp / NXCD, r = nwgp % NXCD, xcd = wgid % NXCD, off = wgid / NXCD; wgid = (xcd < r ? xcd * (q + 1) : r * (q + 1) + (xcd - r) * q) + off; }
        const int nig = wgm * nN, gid = wgid / nig, fm = gid * wgm, gsz = (nMp - fm) < wgm ? (nMp - fm) : wgm;
        const int sl = smp ? j % nsplit : 0;
        const int pmp = fm + ((wgid % nig) % gsz);
        u.pm = smp ? nMp : (rev ? nMp - 1 - pmp : pmp); u.pn = smp ? j / nsplit : (wgid % nig) / gsz; u.slice = sl; u.nsplit = smp ? nsplit : 1; u.kt0 = sl * nks; u.nkt = smp ? nks : nkt; return true;
    }
    __device__ __forceinline__ void a_ready(const Unit&) const {}
    __device__ __forceinline__ void done(const Unit&) const {}
};
struct SplitK { float* part; unsigned* cnt; };
__device__ __forceinline__ bool splitk_fixup(f32x4 (&acc)[2][2][4][2], const Unit& u, const SplitK& sk, int wid, int lane_) {
    (void)lane_; const int lane = fresh_tid() & 63;
    typedef unsigned long long u64;
    u64* mine = (u64*)(sk.part + ((size_t)(u.pn * u.nsplit + u.slice) * 8 + wid) * 8192) + lane;
#pragma unroll
    for (int q = 0; q < 32; ++q) { const f32x4 v = acc[q >> 4][(q >> 3) & 1][(q >> 1) & 3][q & 1];
        __hip_atomic_store(mine + (2 * q) * 64, ((u64)__float_as_uint(v[1]) << 32) | __float_as_uint(v[0]), __ATOMIC_RELAXED, __HIP_MEMORY_SCOPE_AGENT);
        __hip_atomic_store(mine + (2 * q + 1) * 64, ((u64)__float_as_uint(v[3]) << 32) | __float_as_uint(v[2]), __ATOMIC_RELAXED, __HIP_MEMORY_SCOPE_AGENT); }
    asm volatile("s_waitcnt vmcnt(0)" ::: "memory");
    unsigned old = 0; if (lane == 0) old = __hip_atomic_fetch_add(sk.cnt + u.pn * 8 + wid, 1u, __ATOMIC_RELAXED, __HIP_MEMORY_SCOPE_AGENT);
    old = (unsigned)__builtin_amdgcn_readfirstlane((int)old);
    if ((old % (unsigned)u.nsplit) != (unsigned)(u.nsplit - 1)) return false;
#pragma unroll
    for (int q = 0; q < 32; ++q) acc[q >> 4][(q >> 3) & 1][(q >> 1) & 3][q & 1] = (f32x4){0.f, 0.f, 0.f, 0.f};
    for (int sl = 0; sl < u.nsplit; ++sl) { u64* p = (u64*)(sk.part + ((size_t)(u.pn * u.nsplit + sl) * 8 + wid) * 8192) + lane;
#pragma unroll
        for (int q = 0; q < 32; ++q) { const u64 a = __hip_atomic_load(p + (2 * q) * 64, __ATOMIC_RELAXED, __HIP_MEMORY_SCOPE_AGENT), b = __hip_atomic_load(p + (2 * q + 1) * 64, __ATOMIC_RELAXED, __HIP_MEMORY_SCOPE_AGENT);
            f32x4& d = acc[q >> 4][(q >> 3) & 1][(q >> 1) & 3][q & 1];
            d[0] += __uint_as_float((unsigned)a); d[1] += __uint_as_float((unsigned)(a >> 32)); d[2] += __uint_as_float((unsigned)b); d[3] += __uint_as_float((unsigned)(b >> 32)); } }
    return true;
}

__device__ __forceinline__ unsigned cvt_pk_bf16(float lo, float hi) { unsigned r; asm volatile("v_cvt_pk_bf16_f32 %0, %1, %2" : "=v"(r) : "v"(lo), "v"(hi)); return r; }

__device__ __forceinline__ float silu_mul(float g, float u) { return g * __builtin_amdgcn_rcpf(1.0f + __builtin_amdgcn_exp2f(-1.4426950408889634f * g)) * u; }

constexpr float ACT_SCALE = 4.0f, WDN_SCALE = 64.0f, H8_SCALE = 4.0f;
constexpr float WI8_CLAMP = 0.1325825214724777f  , WI8_Q = 127.0f / WI8_CLAMP, WI8_DQ = WI8_CLAMP / 127.0f;
__device__ __forceinline__ unsigned pk4_fp8(float a, float b, float c, float d) {
    a = __builtin_fminf(__builtin_fmaxf(a, -448.f), 448.f); b = __builtin_fminf(__builtin_fmaxf(b, -448.f), 448.f); c = __builtin_fminf(__builtin_fmaxf(c, -448.f), 448.f); d = __builtin_fminf(__builtin_fmaxf(d, -448.f), 448.f);
    int w = __builtin_amdgcn_cvt_pk_fp8_f32(a, b, 0, false); w = __builtin_amdgcn_cvt_pk_fp8_f32(c, d, w, true); return (unsigned)w; }
struct EpiSwiGLU {
    static constexpr bool PERM = true, AFTER_DRAIN = false, HAS_PRE = true;
    unsigned char* O; float inv; const float* rs;
    __device__ __forceinline__ void pre(const Unit& u, int wr, float (&p)[8]) const {
        const int fr = fresh_tid() & 15, row0 = u.pm * BM + wr * 64 + fr;
#pragma unroll
        for (int i = 0; i < 8; ++i) p[i] = rs[row0 + (i >> 2) * HALF + (i & 3) * 16];
    }
    __device__ __forceinline__ void operator()(const f32x4 (&acc)[2][2][4][2], const Unit& u, int wr, int wc, int fr_, int fq_, const float (&pre_)[8]) const {
        (void)fr_; (void)fq_; const int l_ = fresh_tid() & 63, fr = l_ & 15, fq = l_ >> 4;
        const int row0 = u.pm * BM + wr * 64 + fr, col0 = u.pn * HALF + wc * 32 + 8 * fq;
#pragma unroll
        for (int ai = 0; ai < 2; ++ai)
#pragma unroll
            for (int m = 0; m < 4; ++m) { unsigned char* rowp = O + (size_t)(row0 + ai * HALF + m * 16) * FF + col0; const float iv = inv * pre_[ai * 4 + m];
                const f32x2 ivn = (f32x2){-1.4426950408889634f * iv, -1.4426950408889634f * iv}, c2 = (f32x2){ACT_SCALE * iv * iv, ACT_SCALE * iv * iv};
                unsigned wq[2];
#pragma unroll
                for (int n = 0; n < 2; ++n) { const f32x4 ag4 = acc[ai][0][m][n], au4 = acc[ai][1][m][n]; float o[4];
#pragma unroll
                    for (int h = 0; h < 2; ++h) { const f32x2 ag = (f32x2){ag4[2 * h], ag4[2 * h + 1]}, au = (f32x2){au4[2 * h], au4[2 * h + 1]};
                        const f32x2 t = ag * ivn; f32x2 e; e.x = __builtin_amdgcn_exp2f(t.x); e.y = __builtin_amdgcn_exp2f(t.y);
                        const f32x2 d = e + 1.0f; f32x2 r; r.x = __builtin_amdgcn_rcpf(d.x); r.y = __builtin_amdgcn_rcpf(d.y);
                        const f32x2 q = (ag * au) * (r * c2); o[2 * h] = q.x; o[2 * h + 1] = q.y; }
                    wq[n] = pk4_fp8(o[0], o[1], o[2], o[3]); }
                u32x2 w; w.x = wq[0]; w.y = wq[1];
                *(u32x2*)rowp = w; }
    }
};
template <bool IN_F32> struct EpiResT {
    static constexpr bool PERM = false, AFTER_DRAIN = false, HAS_PRE = false;
    const void* xin_p; const void* xin_s; bf16_t* out; const float* gate; float coef;
    __device__ __forceinline__ void operator()(const f32x4 (&acc)[2][2][4][2], const Unit& u, int wr, int wc, int fr_, int fq_) const {
        (void)fr_; (void)fq_; const int l_ = fresh_tid() & 63, fr = l_ & 15, fq = l_ >> 4;
        const int col0 = u.pn * BM + wc * 32 + 4 * fq;
        const bool prm = u.pm < MP / BM;
#pragma unroll
        for (int ai = 0; ai < 2; ++ai)
#pragma unroll
            for (int m = 0; m < 4; ++m) {
                const int rl = ai * HALF + wr * 64 + m * 16 + fr, row = u.pm * BM + rl;
                const int b = prm ? (u.pm >> 3) : NB_P + (rl >> 5);
                const size_t xoff = (prm ? (size_t)row * D : (size_t)(row - MP) * D) + col0;
                const float* gr = gate + (size_t)b * NMOD + col0;
                bf16_t* orow = out + (size_t)row * D + col0;
#pragma unroll
                for (int bj = 0; bj < 2; ++bj)
#pragma unroll
                    for (int n = 0; n < 2; ++n) { f32x4 xv;
                        if (IN_F32) xv = __builtin_nontemporal_load((const f32x4*)((const float*)(prm ? xin_p : xin_s) + xoff + bj * HALF + n * 16));
                        else { const u32x2 w = *(const u32x2*)((const bf16_t*)(prm ? xin_p : xin_s) + xoff + bj * HALF + n * 16); xv = (f32x4){bflo(w.x), bfhi(w.x), bflo(w.y), bfhi(w.y)}; }
                        const f32x4 gv = *(const f32x4*)(gr + bj * HALF + n * 16);
                        const f32x4 r = xv + (gv * coef) * acc[ai][bj][m][n];
                        u32x2 o; o.x = cvt_pk_bf16(r[0], r[1]); o.y = cvt_pk_bf16(r[2], r[3]); *(u32x2*)(orow + bj * HALF + n * 16) = o; }
                asm volatile("" ::: "memory"); }
    }
};
struct EpiWin {
    static constexpr bool PERM = true, AFTER_DRAIN = false, HAS_PRE = false;
    bf16_t* UV; bf16_t* GLU; bf16_t* GLUS; float* out_cp; float* out_cs;
    __device__ __forceinline__ void operator()(const f32x4 (&acc)[2][2][4][2], const Unit& u, int wr, int wc, int fr_, int fq_) const {
        (void)fr_; (void)fq_; const int l_ = fresh_tid() & 63, fr = l_ & 15, fq = l_ >> 4;
        if (u.pn < 8) {
            const int row0 = u.pm * BM + wr * 64 + fr, col0 = u.pn * BM + wc * 32 + 8 * fq;
#pragma unroll
            for (int ai = 0; ai < 2; ++ai)
#pragma unroll
                for (int m = 0; m < 4; ++m) { bf16_t* rowp = UV + (size_t)(row0 + ai * HALF + m * 16) * 2048 + col0;
#pragma unroll
                    for (int bj = 0; bj < 2; ++bj) { const f32x4 v0 = acc[ai][bj][m][0], v1 = acc[ai][bj][m][1];
                        u32x4 w; w.x = cvt_pk_bf16(v0[0], v0[1]); w.y = cvt_pk_bf16(v0[2], v0[3]); w.z = cvt_pk_bf16(v1[0], v1[1]); w.w = cvt_pk_bf16(v1[2], v1[3]);
                        *(u32x4*)(rowp + bj * HALF) = w; } }
        } else {
            const int ch0 = (u.pn - 8) * HALF + wc * 32 + 8 * fq;
            const bool prm = u.pm < MP / BM;
#pragma unroll
            for (int ai = 0; ai < 2; ++ai)
#pragma unroll
                for (int m = 0; m < 4; ++m) {
                    const int rl = ai * HALF + wr * 64 + m * 16 + fr, row = u.pm * BM + rl;
                    const f32x4 a0 = acc[ai][0][m][0], a1 = acc[ai][0][m][1], b0 = acc[ai][1][m][0], b1 = acc[ai][1][m][1];
                    f32x4 g0, g1;
#pragma unroll
                    for (int j = 0; j < 4; ++j) { g0[j] = a0[j] * fsigmoid(b0[j]); g1[j] = a1[j] * fsigmoid(b1[j]); }
                    u32x4 w; w.x = cvt_pk_bf16(g0[0], g0[1]); w.y = cvt_pk_bf16(g0[2], g0[3]); w.z = cvt_pk_bf16(g1[0], g1[1]); w.w = cvt_pk_bf16(g1[2], g1[3]);
                    *(u32x4*)(prm ? GLU + (size_t)row * DB + ch0 : GLUS + ((size_t)(rl >> 5) * 62 + 30 + (rl & 31)) * DB + ch0) = w;
                    float* so = nullptr;
                    if (prm) { const int t = ((u.pm & 7) << 8) + rl; if (t >= SEQ - 30) so = out_cp + ((size_t)(u.pm >> 3) * 30 + (t - (SEQ - 30))) * DB + ch0; }
                    else { const int tl = rl & 31; if (tl >= 2) so = out_cs + ((size_t)(rl >> 5) * 30 + (tl - 2)) * DB + ch0; }
                    if (so) { *(f32x4*)so = g0; *(f32x4*)(so + 4) = g1; }
                }
        }
    }
};
template <class Epi, class Sched, bool ALIGN_EPI = false, bool SP2 = false, bool FP8 = false, bool I8 = false>
__device__ __forceinline__ void gemm_phase(PG8_LAS unsigned char* lds, const Gemm g, const Sched& S, const Epi& E, const SplitK sk) {
    const int tid = fresh_tid(), wid = __builtin_amdgcn_readfirstlane(tid >> 6), lane = tid & 63, wr = wid >> 2, wc = wid & 3, fr = lane & 15, fq = lane >> 4;
    const int K = g.K, pitch = (FP8 || I8) ? K : 2 * K;
    unsigned voffA[2], voffB[2];
#pragma unroll
    for (int i = 0; i < 2; ++i) { int R, C; stage_rc(tid * 16 + i * 8192, R, C); const int Rb = Epi::PERM ? ((R & ~31) + perm32(R & 31)) : R;
        voffA[i] = (unsigned)(R * pitch + C * 2); voffB[i] = (unsigned)(Rb * pitch + C * 2); }
    const size_t kstep = (size_t)(BK * 2);
    const size_t hstep = (size_t)HALF * pitch;
    const size_t tstep = 2 * hstep;
    const unsigned ldsw = (unsigned)wid * 1024u;
    const int aoff = lds_byte(wr * 64 + fr, fq * 8), boff = lds_byte(wc * 32 + fr, fq * 8);
#define PG8_SA(b, h) (((b) * 2 + (h)) * HTB)
#define PG8_SB(b, h) ((4 + (b) * 2 + (h)) * HTB)
#define PG8_STAGE(bufoff, gbase, voff) do { _Pragma("unroll") for (int _i = 0; _i < 2; ++_i) \
        __builtin_amdgcn_global_load_lds((const unsigned*)((const char*)(gbase) + (voff)[_i]), (PG8_LAS unsigned*)(lds + (bufoff) + ldsw + _i * 8192), 16, 0, 0); } while (0)
#define PG8_LD8(addr) __builtin_shufflevector(*(const PG8_LAS i32x4_*)(addr), *(const PG8_LAS i32x4_*)((addr) + 1024), 0, 1, 2, 3, 4, 5, 6, 7)
#define PG8_LDA(dst, b, h) do { if constexpr (FP8) { _Pragma("unroll") for (int m = 0; m < 4; ++m) dst##8[m] = PG8_LD8(lds + PG8_SA(b, h) + aoff + m * 2048); } \
        else { _Pragma("unroll") for (int m = 0; m < 4; ++m) _Pragma("unroll") for (int k = 0; k < 2; ++k) dst[m][k] = *(const PG8_LAS bf16x8*)(lds + PG8_SA(b, h) + aoff + m * 2048 + k * 1024); } } while (0)
#define PG8_LDB(dst, b, h) do { if constexpr (FP8) { _Pragma("unroll") for (int n = 0; n < 2; ++n) dst##8[n] = PG8_LD8(lds + PG8_SB(b, h) + boff + n * 2048); } \
        else { _Pragma("unroll") for (int n = 0; n < 2; ++n) _Pragma("unroll") for (int k = 0; k < 2; ++k) dst[n][k] = *(const PG8_LAS bf16x8*)(lds + PG8_SB(b, h) + boff + n * 2048 + k * 1024); } } while (0)
#define PG8_MMA(ai, bj, At, Bt) do { __builtin_amdgcn_s_setprio(1); _Pragma("unroll") for (int m = 0; m < 4; ++m) _Pragma("unroll") for (int n = 0; n < 2; ++n) { \
        if constexpr (FP8) asm volatile("v_mfma_f32_16x16x128_f8f6f4 %0, %1, %2, %0" : "+v"(acc[ai][bj][m][n]) : "v"(Bt##8[n]), "v"(At##8[m]));   \
        else if constexpr (I8) { _Pragma("unroll") for (int k = 0; k < 2; ++k) acc[ai][bj][m][n] = __builtin_bit_cast(f32x4, __builtin_amdgcn_mfma_i32_16x16x64_i8(__builtin_bit_cast(i32x4_, Bt[n][k]), __builtin_bit_cast(i32x4_, At[m][k]), __builtin_bit_cast(i32x4_, acc[ai][bj][m][n]), 0, 0, 0)); } \
        else { _Pragma("unroll") for (int k = 0; k < 2; ++k) acc[ai][bj][m][n] = __builtin_amdgcn_mfma_f32_16x16x32_bf16(Bt[n][k], At[m][k], acc[ai][bj][m][n], 0, 0, 0); } } \
        __builtin_amdgcn_s_setprio(0); } while (0)
#define PG8_WAIT_V(n) asm volatile("s_waitcnt vmcnt(" #n ")" ::: "memory")
#define PG8_WAIT_L(n) asm volatile("s_waitcnt lgkmcnt(" #n ")" ::: "memory")
#define PG8_BAR __builtin_amdgcn_s_barrier()
#define PG8_SCHED __builtin_amdgcn_sched_barrier(0)
    Unit cur, nxt; int ui = 0;
    if (!S.next(0, cur)) return;
    f32x4 acc[2][2][4][2];
#pragma unroll
    for (int a = 0; a < 2; ++a)
#pragma unroll
        for (int b = 0; b < 2; ++b)
#pragma unroll
            for (int m = 0; m < 4; ++m)
#pragma unroll
                for (int n = 0; n < 2; ++n) acc[a][b][m][n] = (f32x4){0.f, 0.f, 0.f, 0.f};
    bf16x8 At[4][2], B0[2][2], B1[2][2];
    typedef int i32x4_ __attribute__((ext_vector_type(4))); typedef int i32x8_ __attribute__((ext_vector_type(8)));
    i32x8_ At8[4], B08[2], B18[2];
    const char* cA = (const char*)g.A + (size_t)cur.pm * tstep + (size_t)cur.kt0 * kstep; const char* cB = (const char*)g.Bt + (size_t)cur.pn * tstep + (size_t)cur.kt0 * kstep;
    S.a_ready(cur);
    if constexpr (SP2) {
        PG8_STAGE(PG8_SB(0, 0), cB, voffB); PG8_STAGE(PG8_SB(0, 1), cB + hstep, voffB); PG8_STAGE(PG8_SA(0, 0), cA, voffA); PG8_STAGE(PG8_SA(0, 1), cA + hstep, voffA);
        if (wr == 1) PG8_BAR;
        PG8_WAIT_V(2); PG8_BAR;
        PG8_STAGE(PG8_SB(1, 0), cB + kstep, voffB); PG8_STAGE(PG8_SA(1, 0), cA + kstep, voffA); PG8_STAGE(PG8_SB(1, 1), cB + hstep + kstep, voffB);
        PG8_WAIT_V(6); PG8_BAR;
    } else {
        PG8_STAGE(PG8_SB(0, 0), cB, voffB); PG8_STAGE(PG8_SA(0, 0), cA, voffA); PG8_STAGE(PG8_SB(0, 1), cB + hstep, voffB); PG8_STAGE(PG8_SA(0, 1), cA + hstep, voffA);
        if (wr == 1) PG8_BAR;
        PG8_WAIT_V(4); PG8_BAR;
        PG8_STAGE(PG8_SB(1, 0), cB + kstep, voffB); PG8_STAGE(PG8_SA(1, 0), cA + kstep, voffA); PG8_STAGE(PG8_SB(1, 1), cB + hstep + kstep, voffB);
        PG8_WAIT_V(6); PG8_BAR;
    }
    float epre[8];
    for (;;) {
        if constexpr (Epi::HAS_PRE) E.pre(cur, wr, epre);
        const bool has_next = S.next(ui + 1, nxt);
        const char* nA = has_next ? (const char*)g.A + (size_t)nxt.pm * tstep + (size_t)nxt.kt0 * kstep : cA; const char* nB = has_next ? (const char*)g.Bt + (size_t)nxt.pn * tstep + (size_t)nxt.kt0 * kstep : cB;
        const int nt = cur.nkt;
        for (int t = 0; t < nt; t += 2) {
            const bool last = (t == nt - 2);
            const char* a1 = cA + (size_t)(t + 1) * kstep;
            const char* a2 = last ? nA : cA + (size_t)(t + 2) * kstep; const char* b2 = last ? nB : cB + (size_t)(t + 2) * kstep;
            const char* a3 = a2 + kstep; const char* b3 = b2 + kstep;
            if (last && has_next) S.a_ready(nxt);
            if constexpr (SP2) {
            PG8_LDB(B0, 0, 0); PG8_LDB(B1, 0, 1); PG8_SCHED; PG8_LDA(At, 0, 0); PG8_STAGE(PG8_SA(1, 1), a1 + hstep, voffA);
            PG8_WAIT_V(8); PG8_WAIT_L(0); PG8_BAR; PG8_MMA(0, 0, At, B0); PG8_MMA(0, 1, At, B1); PG8_BAR; PG8_SCHED;
            PG8_LDA(At, 0, 1); PG8_STAGE(PG8_SB(0, 0), b2, voffB); PG8_STAGE(PG8_SB(0, 1), b2 + hstep, voffB); PG8_STAGE(PG8_SA(0, 0), a2, voffA);
            PG8_WAIT_V(8); PG8_WAIT_L(0); PG8_BAR; PG8_MMA(1, 0, At, B0); PG8_MMA(1, 1, At, B1); PG8_BAR; PG8_SCHED;
            PG8_LDB(B0, 1, 0); PG8_LDB(B1, 1, 1); PG8_SCHED; PG8_LDA(At, 1, 0); PG8_STAGE(PG8_SA(0, 1), a2 + hstep, voffA);
            PG8_WAIT_V(8); PG8_WAIT_L(0); PG8_BAR; PG8_MMA(0, 0, At, B0); PG8_MMA(0, 1, At, B1); PG8_BAR; PG8_SCHED;
            PG8_LDA(At, 1, 1); PG8_STAGE(PG8_SB(1, 0), b3, voffB); PG8_STAGE(PG8_SB(1, 1), b3 + hstep, voffB); PG8_STAGE(PG8_SA(1, 0), a3, voffA);
            PG8_WAIT_V(8); PG8_WAIT_L(0); PG8_BAR; PG8_MMA(1, 0, At, B0); PG8_MMA(1, 1, At, B1); PG8_BAR; PG8_SCHED;
            } else {
            PG8_LDB(B0, 0, 0); PG8_SCHED; PG8_LDA(At, 0, 0); PG8_STAGE(PG8_SA(1, 1), a1 + hstep, voffA);
            PG8_WAIT_L(8); PG8_BAR; PG8_WAIT_L(0); PG8_MMA(0, 0, At, B0); PG8_BAR; PG8_SCHED;
            PG8_LDB(B1, 0, 1); PG8_STAGE(PG8_SB(0, 0), b2, voffB);
            PG8_BAR; PG8_WAIT_L(0); PG8_MMA(0, 1, At, B1); PG8_BAR;
            PG8_LDA(At, 0, 1); PG8_STAGE(PG8_SA(0, 0), a2, voffA);
            PG8_BAR; PG8_WAIT_L(0); PG8_MMA(1, 0, At, B0); PG8_BAR; PG8_SCHED;
            PG8_STAGE(PG8_SB(0, 1), b2 + hstep, voffB);
            PG8_WAIT_V(6); PG8_BAR; PG8_MMA(1, 1, At, B1); PG8_BAR;
            PG8_LDB(B0, 1, 0); PG8_SCHED; PG8_LDA(At, 1, 0); PG8_STAGE(PG8_SA(0, 1), a2 + hstep, voffA);
            PG8_WAIT_L(8); PG8_BAR; PG8_WAIT_L(0); PG8_MMA(0, 0, At, B0); PG8_BAR; PG8_SCHED;
            PG8_LDB(B1, 1, 1); PG8_STAGE(PG8_SB(1, 0), b3, voffB);
            PG8_BAR; PG8_WAIT_L(0); PG8_MMA(0, 1, At, B1); PG8_BAR;
            PG8_LDA(At, 1, 1); PG8_STAGE(PG8_SA(1, 0), a3, voffA);
            PG8_BAR; PG8_WAIT_L(0); PG8_MMA(1, 0, At, B0); PG8_BAR; PG8_SCHED;
            PG8_STAGE(PG8_SB(1, 1), b3 + hstep, voffB);
            PG8_WAIT_V(6); PG8_BAR; PG8_MMA(1, 1, At, B1); PG8_BAR;
            }
        }
        if constexpr (I8) {
            _Pragma("unroll") for (int a_ = 0; a_ < 2; ++a_) _Pragma("unroll") for (int b_ = 0; b_ < 2; ++b_) _Pragma("unroll") for (int m_ = 0; m_ < 4; ++m_) _Pragma("unroll") for (int n_ = 0; n_ < 2; ++n_) {
                const i32x4_ iv_ = __builtin_bit_cast(i32x4_, acc[a_][b_][m_][n_]); acc[a_][b_][m_][n_] = (f32x4){(float)iv_[0], (float)iv_[1], (float)iv_[2], (float)iv_[3]}; } }
        if constexpr (FP8) asm volatile("s_nop 15\n\ts_nop 15\n\ts_nop 15" ::: "memory");
        if constexpr (ALIGN_EPI) { if (wr == 0) PG8_BAR; }
        if constexpr (!Epi::AFTER_DRAIN) { bool do_epi = true; if (cur.nsplit > 1) do_epi = splitk_fixup(acc, cur, sk, wid, lane); if (do_epi) { if constexpr (Epi::HAS_PRE) E(acc, cur, wr, wc, fr, fq, epre); else E(acc, cur, wr, wc, fr, fq); } S.done(cur); }
        if (!has_next) break;
#pragma unroll
        for (int a = 0; a < 2; ++a)
#pragma unroll
            for (int b = 0; b < 2; ++b)
#pragma unroll
                for (int m = 0; m < 4; ++m)
#pragma unroll
                    for (int n = 0; n < 2; ++n) acc[a][b][m][n] = (f32x4){0.f, 0.f, 0.f, 0.f};
        cur = nxt; cA = nA; cB = nB; ++ui;
        if constexpr (ALIGN_EPI) { if (wr == 1) PG8_BAR; }
    }
    PG8_WAIT_V(0);
    if constexpr (!ALIGN_EPI) { if (wr == 0) PG8_BAR; }
    PG8_BAR;
    if constexpr (Epi::AFTER_DRAIN) { E.fused(acc, cur, wr, wc, fr, fq, lds, wid, lane); S.done(cur); }
#undef PG8_SA
#undef PG8_SB
#undef PG8_STAGE
#undef PG8_LDA
#undef PG8_LD8
#undef PG8_LDB
#undef PG8_MMA
#undef PG8_WAIT_V
#undef PG8_WAIT_L
#undef PG8_BAR
#undef PG8_SCHED
}
}

struct Args { const float* in[26]; float* out; unsigned char* ws; int ph_lo, ph_hi; };
constexpr int NPH = 12;
typedef short bf16x8 __attribute__((ext_vector_type(8)));

__device__ __forceinline__ void transpose_item(const float* W, int K, int N, bf16* WT, int k0, int n0s, int n0d, LAS float* scr, int lane) {
    const int kr = lane >> 4, n4 = (lane & 15) * 4;
    f32x4 v[16];
#pragma unroll
    for (int i = 0; i < 16; ++i) v[i] = *(const f32x4*)(W + (size_t)(k0 + 4 * i + kr) * N + n0s + n4);
#pragma unroll
    for (int i = 0; i < 16; ++i) { LAS float* d = scr + (4 * i + kr) * 65 + n4; d[0] = v[i][0]; d[1] = v[i][1]; d[2] = v[i][2]; d[3] = v[i][3]; }
    asm volatile("s_waitcnt lgkmcnt(0)" ::: "memory");
    const int c = lane & 7;
#pragma unroll
    for (int j = 0; j < 8; ++j) { const int n = (lane >> 3) + 8 * j; const LAS float* sp = scr + (8 * c) * 65 + n;
        u32x4 o; o.x = pk2(sp[0 * 65], sp[1 * 65]); o.y = pk2(sp[2 * 65], sp[3 * 65]); o.z = pk2(sp[4 * 65], sp[5 * 65]); o.w = pk2(sp[6 * 65], sp[7 * 65]);
        *(u32x4*)(WT + (size_t)(n0d + n) * K + k0 + 8 * c) = o; }
    asm volatile("s_waitcnt lgkmcnt(0)" ::: "memory");
}
__device__ __forceinline__ void transpose_item_fp8(const float* W, int K, int N, unsigned char* WT, int k0, int n0s, int n0d, LAS float* scr, int lane) {
    const int kr = lane >> 4, n4 = (lane & 15) * 4;
    f32x4 v[16];
#pragma unroll
    for (int i = 0; i < 16; ++i) v[i] = *(const f32x4*)(W + (size_t)(k0 + 4 * i + kr) * N + n0s + n4);
#pragma unroll
    for (int i = 0; i < 16; ++i) { LAS float* d = scr + (4 * i + kr) * 65 + n4; d[0] = v[i][0]; d[1] = v[i][1]; d[2] = v[i][2]; d[3] = v[i][3]; }
    asm volatile("s_waitcnt lgkmcnt(0)" ::: "memory");
    const int c = lane & 7;
#pragma unroll
    for (int j = 0; j < 8; ++j) { const int n = (lane >> 3) + 8 * j; const LAS float* sp = scr + (8 * c) * 65 + n;
        u32x2 o; o.x = pg8::pk4_fp8(sp[0 * 65] * pg8::WDN_SCALE, sp[1 * 65] * pg8::WDN_SCALE, sp[2 * 65] * pg8::WDN_SCALE, sp[3 * 65] * pg8::WDN_SCALE);
        o.y = pg8::pk4_fp8(sp[4 * 65] * pg8::WDN_SCALE, sp[5 * 65] * pg8::WDN_SCALE, sp[6 * 65] * pg8::WDN_SCALE, sp[7 * 65] * pg8::WDN_SCALE);
        *(u32x2*)(WT + (size_t)(n0d + n) * K + k0 + 8 * c) = o; }
    asm volatile("s_waitcnt lgkmcnt(0)" ::: "memory");
}
__device__ __forceinline__ unsigned pk4_i8(float a, float b, float c, float d) {
    a = __builtin_fminf(__builtin_fmaxf(a * pg8::WI8_Q, -127.f), 127.f); b = __builtin_fminf(__builtin_fmaxf(b * pg8::WI8_Q, -127.f), 127.f);
    c = __builtin_fminf(__builtin_fmaxf(c * pg8::WI8_Q, -127.f), 127.f); d = __builtin_fminf(__builtin_fmaxf(d * pg8::WI8_Q, -127.f), 127.f);
    return (__float_as_uint(a + 12582912.0f) & 0xffu) | ((__float_as_uint(b + 12582912.0f) & 0xffu) << 8) | ((__float_as_uint(c + 12582912.0f) & 0xffu) << 16) | ((__float_as_uint(d + 12582912.0f) & 0xffu) << 24); }
__device__ __forceinline__ void transpose_item_i8(const float* W, int K, int N, unsigned char* WT, int k0, int n0s, int n0d, LAS float* scr, int lane) {
    const int kr = lane >> 4, n4 = (lane & 15) * 4;
    f32x4 v[16];
#pragma unroll
    for (int i = 0; i < 16; ++i) v[i] = *(const f32x4*)(W + (size_t)(k0 + 4 * i + kr) * N + n0s + n4);
#pragma unroll
    for (int i = 0; i < 16; ++i) { LAS float* d = scr + (4 * i + kr) * 65 + n4; d[0] = v[i][0]; d[1] = v[i][1]; d[2] = v[i][2]; d[3] = v[i][3]; }
    asm volatile("s_waitcnt lgkmcnt(0)" ::: "memory");
    const int c = lane & 7;
#pragma unroll
    for (int j = 0; j < 8; ++j) { const int n = (lane >> 3) + 8 * j; const LAS float* sp = scr + (8 * c) * 65 + n;
        u32x2 o; o.x = pk4_i8(sp[0 * 65], sp[1 * 65], sp[2 * 65], sp[3 * 65]); o.y = pk4_i8(sp[4 * 65], sp[5 * 65], sp[6 * 65], sp[7 * 65]);
        *(u32x2*)(WT + (size_t)(n0d + n) * K + k0 + 8 * c) = o; }
    asm volatile("s_waitcnt lgkmcnt(0)" ::: "memory");
}
__device__ __forceinline__ int map_up(int n) { const int pn = n >> 8, s = (n >> 7) & 1, j = n & 127; return s * FF + 128 * pn + j; }
__device__ __forceinline__ int map_win(int n) { if (n < 2048) return n; const int t = n - 2048, q = t >> 8, s = (t >> 7) & 1, j = t & 127; return 2048 + 1024 * s + 128 * q + j; }

__device__ __forceinline__ void mod_item(const Args& a, LAS unsigned char* lds, int cb, int tid, int wave, int lane) {
    const float* cp = a.in[3]; const float* cs = a.in[4]; const float* w_ada = a.in[5]; const float* b_ada = a.in[6];
    float* mod = (float*)(a.ws + WS_MOD);
    LAS float* sl = (LAS float*)lds;
    f32x2 acc[NBT];
#pragma unroll
    for (int b = 0; b < NBT; ++b) acc[b] = (f32x2){0.f, 0.f};
    for (int kc = 0; kc < D; kc += 512) {
#pragma unroll
        for (int b = 0; b < NBT; ++b) { const float c = b < NB_P ? cp[b * D + kc + tid] : cs[(b - NB_P) * D + kc + tid]; sl[tid * NBT + b] = c * fsigmoid(c); }
        __syncthreads();
        const float* wp = w_ada + (size_t)(kc + 64 * wave) * NMOD + 128 * cb + 2 * lane;
#pragma unroll 1
        for (int k8 = 0; k8 < 64; k8 += 16) {
            f32x2 wv[16];
#pragma unroll
            for (int u = 0; u < 16; ++u) wv[u] = __builtin_nontemporal_load((const f32x2*)(wp + (size_t)(k8 + u) * NMOD));
#pragma unroll
            for (int u = 0; u < 16; ++u) {
                const LAS f32x4* sp = (const LAS f32x4*)(sl + (64 * wave + k8 + u) * NBT);
#pragma unroll
                for (int q = 0; q < NBT / 4; ++q) { const f32x4 s4 = sp[q]; acc[4 * q + 0] += s4[0] * wv[u]; acc[4 * q + 1] += s4[1] * wv[u]; acc[4 * q + 2] += s4[2] * wv[u]; acc[4 * q + 3] += s4[3] * wv[u]; }
            }
        }
        __syncthreads();
    }
    LAS float* red = (LAS float*)lds;
#pragma unroll
    for (int b = 0; b < NBT; ++b) *(LAS f32x2*)(red + (wave * NBT + b) * 128 + 2 * lane) = acc[b];
    __syncthreads();
#pragma unroll
    for (int i = 0; i < 6; ++i) { const int o = tid + 512 * i, b = o >> 7, col = o & 127; float s = b_ada[128 * cb + col];
#pragma unroll
        for (int w = 0; w < 8; ++w) s += red[(w * NBT + b) * 128 + col];
        mod[(size_t)b * NMOD + 128 * cb + col] = s; }
    __syncthreads();
}

__device__ __forceinline__ void p0_prologue(const Args& a, LAS unsigned char* lds, int G, int bid, int tid, int wave, int lane) {
    for (int cb = bid; cb < NMOD / 128; cb += G) mod_item(a, lds, cb, tid, wave, lane);
    { const float* w_s = a.in[13]; bf16* wsm = (bf16*)(a.ws + WS_WSM);
      for (int i = bid * 512 + tid; i < NG * 128 * 128; i += G * 512) { const int ii = (i >> 7) & 127, jj = i & 127; wsm[i] = (bf16)(jj <= ii ? f2bf(w_s[i]) : 0u); } }
    { const float* cache = a.in[2]; bf16* gs = (bf16*)(a.ws + WS_GLUS);
      for (int i = bid * 512 + tid; i < NB_S * 30 * DB; i += G * 512) { const int bs = i / (30 * DB), rem = i - bs * 30 * DB; gs[(size_t)bs * 62 * DB + rem] = (bf16)f2bf(cache[i]); } }
    LAS float* scr = (LAS float*)(lds + wave * 16640);
    unsigned* ctr = (unsigned*)(a.ws + WS_CTL);
    constexpr int I_UP = (D / 64) * (2 * FF / 64), I_DN = (FF / 64) * (D / 64), I_IN = (D / 64) * (4096 / 64), I_OUT = (D / 64) * (D / 64);
    constexpr int NITEMS = 2 * I_UP + 2 * I_DN + I_IN + I_OUT;
    struct Item { const float* W; unsigned char* WT; int K, N, k0, n0s, n0d, kind; };
    auto decode = [&](int it) -> Item {
        Item t; int r = it;
        if (r < 2 * I_UP) { const int which = r >= I_UP; r -= which * I_UP; const int nblk = 2 * FF / 64, kb = r / nblk, nb = r % nblk;
            t.W = a.in[which ? 23 : 8]; t.WT = a.ws + (which ? WS_WUP2 : WS_WUP1); t.K = D; t.N = 2 * FF; t.k0 = 64 * kb; t.n0s = map_up(64 * nb); t.n0d = 64 * nb; t.kind = 2; return t; }
        r -= 2 * I_UP;
        if (r < 2 * I_DN) { const int which = r >= I_DN; r -= which * I_DN; const int nblk = D / 64, kb = r / nblk, nb = r % nblk;
            t.W = a.in[which ? 24 : 9]; t.WT = a.ws + (which ? WS_WDN2 : WS_WDN1); t.K = FF; t.N = D; t.k0 = 64 * kb; t.n0s = 64 * nb; t.n0d = 64 * nb; t.kind = 1; return t; }
        r -= 2 * I_DN;
        if (r < I_IN) { const int nblk = 4096 / 64, kb = r / nblk, nb = r % nblk;
            t.W = a.in[11]; t.WT = a.ws + WS_WIN; t.K = D; t.N = 4096; t.k0 = 64 * kb; t.n0s = map_win(64 * nb); t.n0d = 64 * nb; t.kind = 0; return t; }
        r -= I_IN;
        { const int nblk = D / 64, kb = r / nblk, nb = r % nblk; t.W = a.in[21]; t.WT = a.ws + WS_WOUT; t.K = D; t.N = D; t.k0 = 64 * kb; t.n0s = 64 * nb; t.n0d = 64 * nb; t.kind = 0; return t; }
    };
    const int kr = lane >> 4, n4 = (lane & 15) * 4, c8 = lane & 7;
    auto issue = [&](const Item& t, f32x4 (&v)[16]) {
#pragma unroll
        for (int i = 0; i < 16; ++i) v[i] = __builtin_nontemporal_load((const f32x4*)(t.W + (size_t)(t.k0 + 4 * i + kr) * t.N + t.n0s + n4)); };
    auto finish = [&](const Item& t, const f32x4 (&v)[16]) {
#pragma unroll
        for (int i = 0; i < 16; ++i) { LAS float* d = scr + (4 * i + kr) * 65 + n4; d[0] = v[i][0]; d[1] = v[i][1]; d[2] = v[i][2]; d[3] = v[i][3]; }
        asm volatile("s_waitcnt lgkmcnt(0)" ::: "memory");
#pragma unroll
        for (int j = 0; j < 8; ++j) { const int n = (lane >> 3) + 8 * j; const LAS float* sp = scr + (8 * c8) * 65 + n;
            const float e0 = sp[0 * 65], e1 = sp[1 * 65], e2 = sp[2 * 65], e3 = sp[3 * 65], e4 = sp[4 * 65], e5 = sp[5 * 65], e6 = sp[6 * 65], e7 = sp[7 * 65];
            if (t.kind == 0) { u32x4 o; o.x = pk2(e0, e1); o.y = pk2(e2, e3); o.z = pk2(e4, e5); o.w = pk2(e6, e7); *(u32x4*)((bf16*)t.WT + (size_t)(t.n0d + n) * t.K + t.k0 + 8 * c8) = o; }
            else { u32x2 o;
                if (t.kind == 1) { o.x = pg8::pk4_fp8(e0 * pg8::WDN_SCALE, e1 * pg8::WDN_SCALE, e2 * pg8::WDN_SCALE, e3 * pg8::WDN_SCALE); o.y = pg8::pk4_fp8(e4 * pg8::WDN_SCALE, e5 * pg8::WDN_SCALE, e6 * pg8::WDN_SCALE, e7 * pg8::WDN_SCALE); }
                else { o.x = pk4_i8(e0, e1, e2, e3); o.y = pk4_i8(e4, e5, e6, e7); }
                *(u32x2*)(t.WT + (size_t)(t.n0d + n) * t.K + t.k0 + 8 * c8) = o; } }
        asm volatile("s_waitcnt lgkmcnt(0)" ::: "memory"); };
    for (;;) {
        int it0 = 0; if (lane == 0) it0 = (int)atomicAdd(ctr, 4u); it0 = __builtin_amdgcn_readfirstlane(it0);
        if (it0 >= NITEMS) break;
        f32x4 va[16], vb[16];
        const Item t0 = decode(it0), t1 = decode(it0 + 1), t2 = decode(it0 + 2), t3 = decode(it0 + 3);
        issue(t0, va); issue(t1, vb);
        finish(t0, va); issue(t2, va);
        finish(t1, vb); issue(t3, vb);
        finish(t2, va);
        finish(t3, vb);
    }
}

template <int MODE  , bool SRC16 = false  >
__device__ __forceinline__ void norm_phase(const void* srcp_, const void* srcs_, const float* g, const float* mod, int sh_off, int sc_off, void* dst, int gw, int ngw, int lane, float* rs = nullptr) {
    for (int it = gw; it < M / 8; it += ngw) {
        const int row0 = it * 8, b = row_batch(row0);
        const float* src = row0 < MP ? (const float*)srcp_ + (size_t)row0 * D : (const float*)srcs_ + (size_t)(row0 - MP) * D;
        const bf16* src16 = row0 < MP ? (const bf16*)srcp_ + (size_t)row0 * D : (const bf16*)srcs_ + (size_t)(row0 - MP) * D; (void)src; (void)src16;
        f32x4 Gv[8], Sv[8];
#pragma unroll
        for (int j = 0; j < 8; ++j) { const int col = 4 * lane + 256 * j; const f32x4 gg = *(const f32x4*)(g + col);
            if (MODE == 1) { Gv[j] = gg; Sv[j] = (f32x4){0.f, 0.f, 0.f, 0.f}; }
            else { const f32x4 sc = *(const f32x4*)(mod + (size_t)b * NMOD + sc_off + col); Gv[j] = gg * (1.0f + sc); Sv[j] = *(const f32x4*)(mod + (size_t)b * NMOD + sh_off + col); } }
#pragma unroll 1
        for (int r4 = 0; r4 < 8; r4 += 4) {
            f32x4 v[4][8];
#pragma unroll
            for (int q = 0; q < 4; ++q) {
                if (SRC16) { const u32x2* xr = (const u32x2*)(src16 + (size_t)(r4 + q) * D) + lane;
#pragma unroll
                    for (int j = 0; j < 8; ++j) { const u32x2 w = (MODE == 1) ? __builtin_nontemporal_load(&xr[64 * j]) : xr[64 * j]; v[q][j] = (f32x4){bflo(w.x), bfhi(w.x), bflo(w.y), bfhi(w.y)}; } }
                else { const f32x4* xr = (const f32x4*)(src + (size_t)(r4 + q) * D) + lane;
#pragma unroll
                    for (int j = 0; j < 8; ++j) v[q][j] = __builtin_nontemporal_load(&xr[64 * j]); } }
#pragma unroll
            for (int q = 0; q < 4; ++q) {
                float ss = 0.f;
#pragma unroll
                for (int j = 0; j < 8; ++j) ss += (v[q][j][0] * v[q][j][0] + v[q][j][1] * v[q][j][1]) + (v[q][j][2] * v[q][j][2] + v[q][j][3] * v[q][j][3]);
                const float rs_ = 1.0f / sqrtf(wave_sum(ss) * (1.0f / D) + EPS);
                if (MODE == 1) { f32x4* o = (f32x4*)((float*)dst + (size_t)(row0 + r4 + q) * D) + lane;
#pragma unroll
                    for (int j = 0; j < 8; ++j) __builtin_nontemporal_store((v[q][j] * rs_) * Gv[j], &o[64 * j]); }
                else if (MODE == 3) { unsigned* o = (unsigned*)((unsigned char*)dst + (size_t)(row0 + r4 + q) * D) + lane;
                    f32x4 y[8]; float mx = 0.f;
#pragma unroll
                    for (int j = 0; j < 8; ++j) { y[j] = (v[q][j] * rs_) * Gv[j] + Sv[j]; mx = fmaxf(mx, fmaxf(fmaxf(fabsf(y[j][0]), fabsf(y[j][1])), fmaxf(fabsf(y[j][2]), fabsf(y[j][3])))); }
#pragma unroll
                    for (int off = 1; off < 64; off <<= 1) mx = fmaxf(mx, __shfl_xor(mx, off));
                    mx = fmaxf(mx, 1e-20f); const float qs = 127.0f / mx;
                    if (lane == 0) rs[row0 + r4 + q] = mx * (1.0f / 127.0f);
#pragma unroll
                    for (int j = 0; j < 8; ++j) {
                        const unsigned b0 = __float_as_uint(y[j][0] * qs + 12582912.0f) & 0xffu, b1 = __float_as_uint(y[j][1] * qs + 12582912.0f) & 0xffu,
                                       b2 = __float_as_uint(y[j][2] * qs + 12582912.0f) & 0xffu, b3 = __float_as_uint(y[j][3] * qs + 12582912.0f) & 0xffu;
                        o[64 * j] = b0 | (b1 << 8) | (b2 << 16) | (b3 << 24); } }
                else if (MODE == 2) { unsigned* o = (unsigned*)((unsigned char*)dst + (size_t)(row0 + r4 + q) * D) + lane;
#pragma unroll
                    for (int j = 0; j < 8; ++j) { const f32x4 y = ((v[q][j] * rs_) * Gv[j] + Sv[j]) * pg8::H8_SCALE; o[64 * j] = pg8::pk4_fp8(y[0], y[1], y[2], y[3]); } }
                else { u32x2* o = (u32x2*)((bf16*)dst + (size_t)(row0 + r4 + q) * D) + lane;
#pragma unroll
                    for (int j = 0; j < 8; ++j) { const f32x4 y = (v[q][j] * rs_) * Gv[j] + Sv[j]; u32x2 w; w.x = pk2(y[0], y[1]); w.y = pk2(y[2], y[3]); o[64 * j] = w; } }
            }
        }
    }
}

__device__ __forceinline__ float halving_reduce32(const float (&v)[32], int lane) {
    float a[16], b[8], c4[4], d[2];
    { const bool hi = (lane & 32) != 0;
#pragma unroll
      for (int i = 0; i < 16; ++i) { const float send = hi ? v[i] : v[16 + i], keep = hi ? v[16 + i] : v[i]; a[i] = keep + __shfl_xor(send, 32); } }
    { const bool hi = (lane & 16) != 0;
#pragma unroll
      for (int i = 0; i < 8; ++i) { const float send = hi ? a[i] : a[8 + i], keep = hi ? a[8 + i] : a[i]; b[i] = keep + __shfl_xor(send, 16); } }
    { const bool hi = (lane & 8) != 0;
#pragma unroll
      for (int i = 0; i < 4; ++i) { const float send = hi ? b[i] : b[4 + i], keep = hi ? b[4 + i] : b[i]; c4[i] = keep + __shfl_xor(send, 8); } }
    { const bool hi = (lane & 4) != 0;
#pragma unroll
      for (int i = 0; i < 2; ++i) { const float send = hi ? c4[i] : c4[2 + i], keep = hi ? c4[2 + i] : c4[i]; d[i] = keep + __shfl_xor(send, 4); } }
    float e; { const bool hi = (lane & 2) != 0; const float send = hi ? d[0] : d[1], keep = hi ? d[1] : d[0]; e = keep + __shfl_xor(send, 2); }
    return e + __shfl_xor(e, 1);
}
constexpr int MX_VS = 0, MX_RJ = 65536, MX_PART = 65536 + 256, MX_RED = 65536 + 4096, MX_STAT = 65536 + 8192;
__device__ __forceinline__ void mixer_chunk(const Args& a, LAS unsigned char* lds, int chunkrow0, int nks, int sbs, int pos0c, int tid_, int wave, int lane_, bool doA = true, bool doB = true) {
    int tid = tid_, lane = lane_; asm volatile("" : "+v"(tid), "+v"(lane));
    const bf16* UV = (const bf16*)(a.ws + WS_UV); const bf16* GLU = (const bf16*)(a.ws + WS_GLU); const bf16* WSM = (const bf16*)(a.ws + WS_WSM);
    bf16* YC = (bf16*)(a.ws + WS_H);
    const float* g_v = a.in[12]; const float* b_s = a.in[14]; const float* w_dw = a.in[15]; const float* b_dw = a.in[16]; const float* g_cn = a.in[17]; const float* b_cn = a.in[18];
    const float* g_oa = a.in[19]; const float* g_ob = a.in[20];
    LAS bf16* vs = (LAS bf16*)(lds + MX_VS); LAS float* rj = (LAS float*)(lds + MX_RJ); LAS float* part = (LAS float*)(lds + MX_PART);
    LAS float* red = (LAS float*)(lds + MX_RED); LAS float* stat = (LAS float*)(lds + MX_STAT);
    const int fr0 = lane & 15, fq0 = lane >> 4, g = wave;
    if (doA)
    {
    bf16x8 bfr[3][8];
    u32x4 stg[8];
#pragma unroll
    for (int i = 0; i < 8; ++i) { const int idx = tid + 512 * i, r = idx >> 7, ch = idx & 127; stg[i] = *(const u32x4*)(UV + (size_t)(chunkrow0 + r) * 2048 + 1024 + 8 * ch); }
#pragma unroll
    for (int ks = 0; ks < 4; ++ks) {
        if (ks < nks) {
        const int ib = ks, rowbase = chunkrow0 + 32 * ib;
        int fr = fr0, fq = fq0; asm volatile("" : "+v"(fr), "+v"(fq));
        __syncthreads();
        asm volatile("" : "+v"(tid));
#pragma unroll
        for (int i = 0; i < 8; ++i) { const int idx = tid + 512 * i, r = idx >> 7, ch = idx & 127;
            *(LAS u32x4*)(vs + r * 1024 + ((8 * ch) ^ (((r >> 3) & 3) << 4))) = stg[i]; }
        __syncthreads();
#pragma unroll
        for (int rr = 0; rr < 4; ++rr) { const int r = 4 * wave + rr; const LAS u32x4* p = (const LAS u32x4*)(vs + r * 1024 + lane * 16); float ss = 0.f;
#pragma unroll
            for (int h = 0; h < 2; ++h) { const u32x4 q = p[h];
#pragma unroll
                for (int e = 0; e < 4; ++e) { const float lo = bflo(q[e]), hi = bfhi(q[e]); ss += lo * lo + hi * hi; } }
            ss = wave_sum(ss); if (lane == 0) rj[r] = 1.0f / sqrtf(ss * (1.0f / DA) + EPS); }
        __syncthreads();
        if (sbs >= 0) {
            float* ov = a.out + OUT_VS + (size_t)sbs * SSEQ * DA;
#pragma unroll
            for (int i = 0; i < 8; ++i) { const int idx = tid + 512 * i, r = idx >> 7, ch = idx & 127;
                const u32x4 q = *(const LAS u32x4*)(vs + r * 1024 + ((8 * ch) ^ (((r >> 3) & 3) << 4))); const float rr = rj[r];
                const f32x4 g0 = *(const f32x4*)(g_v + 8 * ch), g1 = *(const f32x4*)(g_v + 8 * ch + 4);
                f32x4 o0, o1; o0[0] = bflo(q[0]) * rr * g0[0]; o0[1] = bfhi(q[0]) * rr * g0[1]; o0[2] = bflo(q[1]) * rr * g0[2]; o0[3] = bfhi(q[1]) * rr * g0[3];
                o1[0] = bflo(q[2]) * rr * g1[0]; o1[1] = bfhi(q[2]) * rr * g1[1]; o1[2] = bflo(q[3]) * rr * g1[2]; o1[3] = bfhi(q[3]) * rr * g1[3];
                *(f32x4*)(ov + (size_t)r * DA + 8 * ch) = o0; *(f32x4*)(ov + (size_t)r * DA + 8 * ch + 4) = o1; }
        }
        f32x4 acc[2][8];
#pragma unroll
        for (int mt = 0; mt < 2; ++mt)
#pragma unroll
            for (int nt = 0; nt < 8; ++nt) acc[mt][nt] = (f32x4){0.f, 0.f, 0.f, 0.f};
        float rjv[8];
#pragma unroll
        for (int jj = 0; jj < 8; ++jj) rjv[jj] = rj[8 * fq + jj];
        { bf16x8 af[2];
#pragma unroll
          for (int mt = 0; mt < 2; ++mt) af[mt] = *(const bf16x8*)(WSM + ((size_t)(g * 128 + 32 * ib + 16 * mt + fr)) * 128 + 32 * ks + 8 * fq);
#pragma unroll
          for (int nt = 0; nt < 8; ++nt) { const int d = g * HD + 16 * nt + fr; const float gvd = g_v[d];
            float f[8];
#pragma unroll
            for (int jj = 0; jj < 8; ++jj) { const unsigned x = vs[(8 * fq + jj) * 1024 + (d ^ (fq << 4))]; f[jj] = __builtin_bit_cast(float, x << 16) * rjv[jj] * gvd; }
            u32x4 bw; bw.x = pk2(f[0], f[1]); bw.y = pk2(f[2], f[3]); bw.z = pk2(f[4], f[5]); bw.w = pk2(f[6], f[7]);
            const bf16x8 bfrag = __builtin_bit_cast(bf16x8, bw);
            if (ks < 3) bfr[ks < 3 ? ks : 0][nt] = bfrag;
#pragma unroll
            for (int mt = 0; mt < 2; ++mt) acc[mt][nt] = __builtin_amdgcn_mfma_f32_16x16x32_bf16(bfrag, af[mt], acc[mt][nt], 0, 0, 0);
            if (nt & 1) asm volatile("" ::: "memory"); } }
#pragma unroll
        for (int k = 0; k < 3; ++k) {
            if (k < ks) { bf16x8 af[2];
#pragma unroll
                for (int mt = 0; mt < 2; ++mt) af[mt] = *(const bf16x8*)(WSM + ((size_t)(g * 128 + 32 * ib + 16 * mt + fr)) * 128 + 32 * k + 8 * fq);
#pragma unroll
                for (int nt = 0; nt < 8; ++nt)
#pragma unroll
                    for (int mt = 0; mt < 2; ++mt) acc[mt][nt] = __builtin_amdgcn_mfma_f32_16x16x32_bf16(bfr[k][nt], af[mt], acc[mt][nt], 0, 0, 0); }
        }
        asm volatile("" ::: "memory");
#pragma unroll
        for (int mt = 0; mt < 2; ++mt) { const float bias = b_s[g * 128 + 32 * ib + 16 * mt + fr]; const int row = rowbase + 16 * mt + fr; float sq = 0.f;
#pragma unroll
            for (int nt = 0; nt < 8; ++nt) { const u32x2 uw = *(const u32x2*)(UV + (size_t)row * 2048 + g * HD + 16 * nt + 4 * fq);
                f32x4 y = acc[mt][nt] + bias; y[0] *= bflo(uw.x); y[1] *= bfhi(uw.x); y[2] *= bflo(uw.y); y[3] *= bfhi(uw.y);
                acc[mt][nt] = y; sq += (y[0] * y[0] + y[1] * y[1]) + (y[2] * y[2] + y[3] * y[3]);
                if ((nt & 3) == 3) asm volatile("" ::: "memory"); }
            sq += __shfl_xor(sq, 16); sq += __shfl_xor(sq, 32);
            if (fq == 0) part[(ks & 1) * 256 + g * 32 + 16 * mt + fr] = sq; }
        __syncthreads();
#pragma unroll
        for (int mt = 0; mt < 2; ++mt) { float tot = 0.f;
#pragma unroll
            for (int w = 0; w < 8; ++w) tot += part[(ks & 1) * 256 + w * 32 + 16 * mt + fr];
            const float ra = 1.0f / sqrtf(tot * (1.0f / DA) + EPS); const int row = rowbase + 16 * mt + fr;
#pragma unroll
            for (int nt = 0; nt < 8; ++nt) { const int d = g * HD + 16 * nt + 4 * fq; const f32x4 go = *(const f32x4*)(g_oa + d); const f32x4 o = (acc[mt][nt] * ra) * go;
                u32x2 w; w.x = pk2(o[0], o[1]); w.y = pk2(o[2], o[3]); *(u32x2*)(YC + (size_t)row * 2048 + d) = w;
                if ((nt & 3) == 3) asm volatile("" ::: "memory"); } }
        if (ks + 1 < nks) {
#pragma unroll
            for (int i = 0; i < 8; ++i) { const int idx = tid + 512 * i, r = idx >> 7, ch = idx & 127; stg[i] = *(const u32x4*)(UV + (size_t)(chunkrow0 + 32 * (ks + 1) + r) * 2048 + 1024 + 8 * ch); } }
        }
    }
    }
    if (doB)
#pragma unroll 1
    for (int ib = 0; ib < nks; ++ib) {
        const int rowbase = chunkrow0 + 32 * ib, pos0 = pos0c + 32 * ib;
    {
        int c = 2 * tid; asm volatile("" : "+v"(c) :: "memory");
        const bool zero_hist = sbs < 0 && pos0 == 0;
        const bf16* xp = (sbs >= 0 ? (const bf16*)(a.ws + WS_GLUS) + ((size_t)sbs * 62 + 30) * DB : GLU + (size_t)rowbase * DB) + c - 30 * DB;
        unsigned xw[62];
#pragma unroll
        for (int si = 0; si < 62; ++si) { xw[si] = *(const unsigned*)xp; xp += DB; asm volatile("" : "+v"(xp)); }
        f32x2 wk[CW];
#pragma unroll
        for (int k = 0; k < CW; ++k) wk[k] = *(const f32x2*)(w_dw + k * DB + c);
        const f32x2 bd = *(const f32x2*)(b_dw + c), gc = *(const f32x2*)(g_cn + c), bc = *(const f32x2*)(b_cn + c), gb = *(const f32x2*)(g_ob + c);
        f32x2 y[32];
#pragma unroll
        for (int t = 0; t < 32; ++t) y[t] = bd;
#pragma unroll
        for (int si = 0; si < 62; ++si) {
            f32x2 x = (f32x2){bflo(xw[si]), bfhi(xw[si])};
            if (si < 30 && zero_hist) x = (f32x2){0.f, 0.f};
#pragma unroll
            for (int t = (si > 30 ? si - 30 : 0); t <= (si < 31 ? si : 31); ++t) y[t] += wk[si - t] * x;
        }
        { float v1[32], v2[32];
#pragma unroll
          for (int t = 0; t < 32; ++t) { v1[t] = y[t][0] + y[t][1]; v2[t] = y[t][0] * y[t][0] + y[t][1] * y[t][1]; }
          const float r1 = halving_reduce32(v1, lane), r2 = halving_reduce32(v2, lane);
          if ((lane & 1) == 0) { red[wave * 64 + (lane >> 1)] = r1; red[wave * 64 + 32 + (lane >> 1)] = r2; } }
        __syncthreads();
        if (tid < 64) { float sacc = 0.f;
#pragma unroll
            for (int w = 0; w < 8; ++w) sacc += red[w * 64 + tid];
            stat[tid] = sacc; }
        __syncthreads();
        { float v3[32];
#pragma unroll
          for (int t = 0; t < 32; ++t) { const float mean = stat[t] * (1.0f / DB), var = stat[32 + t] * (1.0f / DB) - mean * mean, rstd = 1.0f / sqrtf(var + EPS);
              f32x2 z = ((y[t] - mean) * rstd) * gc + bc; z[0] *= fsigmoid(z[0]); z[1] *= fsigmoid(z[1]); y[t] = z; v3[t] = z[0] * z[0] + z[1] * z[1]; }
          const float r3 = halving_reduce32(v3, lane);
          if ((lane & 1) == 0) red[512 + wave * 32 + (lane >> 1)] = r3; }
        __syncthreads();
        if (tid < 32) { float sacc = 0.f;
#pragma unroll
            for (int w = 0; w < 8; ++w) sacc += red[512 + w * 32 + tid];
            stat[64 + tid] = sacc; }
        __syncthreads();
#pragma unroll
        for (int t = 0; t < 32; ++t) { const float rb = 1.0f / sqrtf(stat[64 + t] * (1.0f / DB) + EPS); const f32x2 o = (y[t] * rb) * gb;
            *(unsigned*)(YC + (size_t)(rowbase + t) * 2048 + DA + c) = pk2(o[0], o[1]); }
    }
        __syncthreads();
    }
}
__device__ __forceinline__ void mixer_phase(const Args& a, LAS unsigned char* lds, int G, int bid, int tid, int wave, int lane) {
    for (int idx = bid; idx < 256 + 2 * NB_S; idx += G) {
        if (idx < 256) { const int b = idx >> 4, ck = idx & 15; mixer_chunk(a, lds, b * SEQ + ck * 128, 4, -1, ck * 128, tid, wave, lane); }
        else { const int h = idx - 256, bs = h >> 1; mixer_chunk(a, lds, MP + 32 * bs, 1, bs, 0, tid, wave, lane, (h & 1) == 0, (h & 1) == 1); }
    }
}


#define XB_TMO      128
#define XB_XCNT(j)  (256  + 64 * (j))
#define XB_XSUB(j)  (1280 + 64 * (j))
#define XB_XGEN(j)  (2304 + 64 * (j))
#define XB_TOP      3328
#define XB_TOPGEN   3392
#define XCD_BAR_WORDS 3456
#define XB_SPIN_CAP (1u << 18)

__device__ __forceinline__ unsigned xb_ld(unsigned* p)              { return __hip_atomic_load(p, __ATOMIC_RELAXED, __HIP_MEMORY_SCOPE_AGENT); }
__device__ __forceinline__ unsigned xb_add(unsigned* p, unsigned v) { return __hip_atomic_fetch_add(p, v, __ATOMIC_RELAXED, __HIP_MEMORY_SCOPE_AGENT); }
__device__ __forceinline__ unsigned xb_xcc_id() { return (unsigned)__builtin_amdgcn_s_getreg((3 << 11) | 20) & 0xFu; }
#define XB_SPIN(cond, bar) do { unsigned _sp = 0; while (cond) { __builtin_amdgcn_s_sleep(1); \
    if ((++_sp & 255u) == 0u) { if (xb_ld(&(bar)[XB_TMO])) break; if (_sp > XB_SPIN_CAP) { atomicAdd(&(bar)[XB_TMO], 1u); break; } } } } while (0)

struct XcdBarrier {
    unsigned* bar; unsigned x;
    volatile LAS unsigned* st;
};

__device__ __forceinline__ XcdBarrier xcd_barrier_post(unsigned* bar, volatile LAS unsigned* st) {
    XcdBarrier b; b.bar = bar; b.x = xb_xcc_id(); b.st = st;
    if (threadIdx.x == 0) (void)xb_add(&bar[XB_XCNT(b.x)], 1u);
    return b;
}
__device__ __forceinline__ void xcd_barrier_complete(unsigned* bar, unsigned x, unsigned& nloc, unsigned& nx) {
    const unsigned G = gridDim.x * gridDim.y * gridDim.z;
    unsigned sum, cnt, mine, sp = 0u;
    for (;;) {
        sum = 0u; cnt = 0u; mine = 0u;
#pragma unroll
        for (unsigned j = 0; j < 16; ++j) { const unsigned c = xb_ld(&bar[XB_XCNT(j)]); sum += c; cnt += (c > 0u) ? 1u : 0u; mine = (j == x) ? c : mine; }
        if (sum == G) break;
        __builtin_amdgcn_s_sleep(1);
        if ((++sp & 255u) == 0u) { if (xb_ld(&bar[XB_TMO])) break; if (sp > XB_SPIN_CAP) { atomicAdd(&bar[XB_TMO], 1u); break; } }
    }
    nloc = mine > 0u ? mine : 1u; nx = cnt > 0u ? cnt : 1u;
}

__device__ __forceinline__ void xcd_barrier(const XcdBarrier& b) {
    asm volatile("s_waitcnt vmcnt(0)" ::: "memory");
    __syncthreads();
    if (threadIdx.x == 0) {
        unsigned* bar = b.bar;
        __builtin_amdgcn_s_waitcnt(0);
        unsigned nloc = b.st[0], nx = b.st[1];
        if (nloc == 0u) { xcd_barrier_complete(bar, b.x, nloc, nx); b.st[0] = nloc; b.st[1] = nx; }
        const unsigned old = xb_add(&bar[XB_XSUB(b.x)], 1u);
        const unsigned gen = old / nloc;
        if (old + 1u == (gen + 1u) * nloc) {
            __builtin_amdgcn_fence(__ATOMIC_RELEASE, "agent");
            asm volatile("s_waitcnt vmcnt(0)" ::: "memory");
            const unsigned og = xb_add(&bar[XB_TOP], 1u);
            const unsigned tg = og / nx;
            if (og + 1u == (tg + 1u) * nx) xb_add(&bar[XB_TOPGEN], 1u);
            else XB_SPIN(xb_ld(&bar[XB_TOPGEN]) == tg, bar);
            __builtin_amdgcn_fence(__ATOMIC_ACQUIRE, "agent");
            xb_add(&bar[XB_XGEN(b.x)], 1u);
            asm volatile("s_waitcnt vmcnt(0)" ::: "memory");
        } else {
            XB_SPIN(xb_ld(&bar[XB_XGEN(b.x)]) == gen, bar);
            __builtin_amdgcn_fence(__ATOMIC_ACQUIRE, "agent");
            asm volatile("s_waitcnt vmcnt(0)" ::: "memory");
        }
    }
    __syncthreads();
}

__global__ void __launch_bounds__(512, 2) mega_fwd(Args a) {
    extern __shared__ __attribute__((aligned(16))) unsigned char lds_raw[];
    LAS unsigned char* lds = (LAS unsigned char*)lds_raw;
    const int G = gridDim.x, bid = blockIdx.x;
#define TIDS const int tid = fresh_tid(), lane = tid & 63, wave = __builtin_amdgcn_readfirstlane(tid >> 6), gw = bid * 8 + wave, ngw = G * 8; (void)gw; (void)ngw; (void)lane
    const int lo = a.ph_lo, hi = a.ph_hi;
    volatile LAS unsigned* MISC = (volatile LAS unsigned*)(lds + LDS_BYTES - 64);
    if (threadIdx.x < 16) MISC[threadIdx.x] = 0u;
    __syncthreads();
    XcdBarrier xbar = xcd_barrier_post((unsigned*)(a.ws + WS_CTL) + 1024, MISC + 8);
    unsigned char* ws = a.ws;
    float* mod = (float*)(ws + WS_MOD);
    bf16* Hb = (bf16*)(ws + WS_H); unsigned char* ACT = ws + WS_ACT;
    bf16* X16 = (bf16*)(ws + WS_X16);
    float* X = a.out; (void)X;
#ifndef PHMASK
#define PHMASK 0xFFF
#endif
#define IN(k) (((PHMASK >> (k)) & 1) && lo <= (k) && (k) < hi)
#define SEAM(k) do { if (IN(k) && IN((k) + 1)) xcd_barrier(xbar); } while (0)
    if (a.ph_hi > 4096) cg::this_grid().sync();
#ifndef DUPMASK
#define DUPMASK 0
#endif
#define REP(k) for (int rep_ = 0; rep_ < 1 + ((DUPMASK >> (k)) & 1); ++rep_)
#define DSYNC(k) do { if (((DUPMASK >> (k)) & 1) && rep_ == 0) xcd_barrier(xbar); } while (0)

    if (IN(0)) REP(0) { TIDS; p0_prologue(a, lds, G, bid, tid, wave, lane); DSYNC(0); }
    SEAM(0);
    if (IN(1)) REP(1) { TIDS; norm_phase<3>(a.in[0], a.in[1], a.in[7], mod, OFF_SH1, OFF_SC1, Hb, gw, ngw, lane, (float*)(ws + WS_RS)); DSYNC(1); }
    SEAM(1);
    if (IN(2)) REP(2) { pg8::Gemm g{Hb, (const bf16*)(ws + WS_WUP1), M, 2 * FF, D}; pg8::MixedOrder S; S.init(MP, 2 * FF, D, 4, G, bid, pg8::WGM, 128); const pg8::SplitK sk{(float*)(ws + WS_PART), (unsigned*)(ws + WS_CTL) + 8192 + 0 * 512};
        pg8::EpiSwiGLU E{ACT, pg8::WI8_DQ, (const float*)(ws + WS_RS)};
        pg8::gemm_phase<pg8::EpiSwiGLU, pg8::MixedOrder, true, true, false, true>(lds, g, S, E, sk); DSYNC(2); }
    SEAM(2);
    if (IN(3)) REP(3) { pg8::Gemm g{(const bf16*)ACT, (const bf16*)(ws + WS_WDN1), M, D, FF}; pg8::MixedOrder S; S.init(MP, D, FF, 11, G, bid, 4, 128); S.rev = 1; const pg8::SplitK sk{(float*)(ws + WS_PART), (unsigned*)(ws + WS_CTL) + 8192 + 1 * 512}; pg8::EpiResT<true> E{a.in[0], a.in[1], X16, mod + OFF_GT1, 0.5f / (pg8::ACT_SCALE * pg8::WDN_SCALE)};
        pg8::gemm_phase<pg8::EpiResT<true>, pg8::MixedOrder, true, true, true>(lds, g, S, E, sk); DSYNC(3); }
    SEAM(3);
    if (IN(4)) REP(4) { TIDS; norm_phase<0, true>(X16, X16 + (size_t)MP * D, a.in[10], mod, OFF_SH2, OFF_SC2, Hb, gw, ngw, lane); DSYNC(4); }
    SEAM(4);
    if (IN(5)) REP(5) { pg8::Gemm g{Hb, (const bf16*)(ws + WS_WIN), M, 4096, D}; pg8::MixedOrder S; S.init(MP, 4096, D, 4, G, bid); const pg8::SplitK sk{(float*)(ws + WS_PART), (unsigned*)(ws + WS_CTL) + 8192 + 2 * 512};
        pg8::EpiWin E{(bf16*)(ws + WS_UV), (bf16*)(ws + WS_GLU), (bf16*)(ws + WS_GLUS), a.out + OUT_CP, a.out + OUT_CS};
        pg8::gemm_phase<pg8::EpiWin, pg8::MixedOrder, true, true>(lds, g, S, E, sk); DSYNC(5); }
    SEAM(5);
    if (IN(6)) REP(6) { TIDS; mixer_phase(a, lds, G, bid, tid, wave, lane); DSYNC(6); }
    SEAM(6);
    if (IN(7)) REP(7) { pg8::Gemm g{Hb, (const bf16*)(ws + WS_WOUT), M, D, D}; pg8::MixedOrder S; S.init(MP, D, D, 4, G, bid); const pg8::SplitK sk{(float*)(ws + WS_PART), (unsigned*)(ws + WS_CTL) + 8192 + 3 * 512}; pg8::EpiResT<false> E{X16, X16 + (size_t)MP * D, X16, mod + OFF_GT2, 1.0f};
        pg8::gemm_phase<pg8::EpiResT<false>, pg8::MixedOrder, true, true>(lds, g, S, E, sk); DSYNC(7); }
    SEAM(7);
    if (IN(8)) REP(8) { TIDS; norm_phase<3, true>(X16, X16 + (size_t)MP * D, a.in[22], mod, OFF_SH3, OFF_SC3, Hb, gw, ngw, lane, (float*)(ws + WS_RS) + M); DSYNC(8); }
    SEAM(8);
    if (IN(9)) REP(9) { pg8::Gemm g{Hb, (const bf16*)(ws + WS_WUP2), M, 2 * FF, D}; pg8::MixedOrder S; S.init(MP, 2 * FF, D, 4, G, bid, pg8::WGM, 128); const pg8::SplitK sk{(float*)(ws + WS_PART), (unsigned*)(ws + WS_CTL) + 8192 + 4 * 512};
        pg8::EpiSwiGLU E{ACT, pg8::WI8_DQ, (const float*)(ws + WS_RS) + M};
        pg8::gemm_phase<pg8::EpiSwiGLU, pg8::MixedOrder, true, true, false, true>(lds, g, S, E, sk); DSYNC(9); }
    SEAM(9);
    if (IN(10)) REP(10) { pg8::Gemm g{(const bf16*)ACT, (const bf16*)(ws + WS_WDN2), M, D, FF}; pg8::MixedOrder S; S.init(MP, D, FF, 11, G, bid, 4, 128); S.rev = 1; const pg8::SplitK sk{(float*)(ws + WS_PART), (unsigned*)(ws + WS_CTL) + 8192 + 5 * 512}; pg8::EpiResT<false> E{X16, X16 + (size_t)MP * D, X16, mod + OFF_GT3, 0.5f / (pg8::ACT_SCALE * pg8::WDN_SCALE)};
        pg8::gemm_phase<pg8::EpiResT<false>, pg8::MixedOrder, true, true, true>(lds, g, S, E, sk); DSYNC(10); }
    SEAM(10);
    if (IN(11)) REP(11) { TIDS; norm_phase<1, true>(X16, X16 + (size_t)MP * D, a.in[25], mod, 0, 0, a.out, gw, ngw, lane); }
#undef IN
#undef SEAM
}

extern "C" void kernel_launch(void* const* d_in, const int* in_sizes, int n_in, void* d_out, int out_size, void* d_ws, size_t ws_size, hipStream_t stream) {
    static int grid = 0;
    if (grid == 0) {
        if (n_in != 26 || in_sizes[0] != MP * D || (size_t)out_size != OUT_END || ws_size < WS_END) {
            fprintf(stderr, "kernel_launch: unexpected shapes (n_in %d, in0 %d, out %d, ws %zu); nothing launched\n", n_in, n_in > 0 ? in_sizes[0] : -1, out_size, ws_size); grid = -1; return; }
        int dev = 0, cus = 0, per_cu = 0;
        if (hipGetDevice(&dev) != hipSuccess || hipDeviceGetAttribute(&cus, hipDeviceAttributeMultiprocessorCount, dev) != hipSuccess) { grid = -1; return; }
        if (hipFuncSetAttribute((const void*)mega_fwd, hipFuncAttributeMaxDynamicSharedMemorySize, LDS_BYTES) != hipSuccess) { fprintf(stderr, "kernel_launch: hipFuncSetAttribute failed\n"); grid = -1; return; }
        if (hipOccupancyMaxActiveBlocksPerMultiprocessor(&per_cu, (const void*)mega_fwd, 512, LDS_BYTES) != hipSuccess || per_cu < 1) { fprintf(stderr, "kernel_launch: occupancy query says %d\n", per_cu); per_cu = 1; }
        (void)hipGetLastError();
        grid = cus * per_cu;
    }
    if (grid < 0) return;
    if (hipMemsetAsync((char*)d_ws + WS_CTL, 0, CTL_BYTES, stream) != hipSuccess) { fprintf(stderr, "kernel_launch: memset failed\n"); return; }
    Args a{};
    for (int i = 0; i < 26; ++i) a.in[i] = (const float*)d_in[i];
    a.out = (float*)d_out; a.ws = (unsigned char*)d_ws;
#if MK_PER_PHASE
    for (int ph = 0; ph < NPH; ++ph) { a.ph_lo = ph; a.ph_hi = ph + 1; hipLaunchKernelGGL(mega_fwd, dim3(grid), dim3(512), LDS_BYTES, stream, a); }
#else
    a.ph_lo = 0; a.ph_hi = NPH;
    void* args[] = {&a};
    hipError_t e = hipLaunchCooperativeKernel((const void*)mega_fwd, dim3(grid), dim3(512), args, LDS_BYTES, stream);
    if (e != hipSuccess) fprintf(stderr, "kernel_launch: cooperative launch failed: %s (grid %d)\n", hipGetErrorString(e), grid);
#endif
}
```

```cpp
#include <hip/hip_runtime.h>
#include <hip/hip_cooperative_groups.h>
#include <cstdio>
#include <cstdint>
namespace cg = cooperative_groups;

#ifndef MK_PER_PHASE
#define MK_PER_PHASE 0
#endif

constexpr int D = 2048, NB_P = 16, SEQ = 2048, NB_S = 8, SSEQ = 32;
constexpr int MP = NB_P * SEQ, MS = NB_S * SSEQ, M = MP + MS;
constexpr int DA = 1024, DB = 1024, NG = 8, HD = 128, FF = 5632, NMOD = 9 * D, CW = 31, NBT = NB_P + NB_S;
constexpr float EPS = 1e-6f;
constexpr int OFF_SH1 = 0, OFF_SC1 = D, OFF_GT1 = 2 * D, OFF_SH2 = 3 * D, OFF_SC2 = 4 * D, OFF_GT2 = 5 * D, OFF_SH3 = 6 * D, OFF_SC3 = 7 * D, OFF_GT3 = 8 * D;
constexpr size_t OUT_Y = 0, OUT_CP = (size_t)M * D, OUT_CS = OUT_CP + (size_t)NB_P * 30 * DB, OUT_VS = OUT_CS + (size_t)NB_S * 30 * DB, OUT_END = OUT_VS + (size_t)NB_S * SSEQ * DA;
constexpr size_t MiB = 1u << 20;
constexpr size_t WS_MOD = 0, WS_CTL = 1835008  , CTL_BYTES = 65536, WS_WSM = 2 * MiB, WS_GLUS = 3 * MiB  , WS_WUP1 = 4 * MiB, WS_WDN1 = 48 * MiB, WS_WIN = 70 * MiB, WS_WOUT = 86 * MiB, WS_WUP2 = 94 * MiB, WS_WDN2 = 138 * MiB;
constexpr size_t WS_H = 160 * MiB, WS_ACT = 289 * MiB, WS_UV = WS_ACT, WS_GLU = WS_ACT + 129 * MiB, WS_PART = 644 * MiB  , WS_RS = 690 * MiB  , WS_X16 = 700 * MiB  , WS_END = 830 * MiB;
static_assert(((D / 64) * (2 * FF / 64) * 2 + (FF / 64) * (D / 64) * 2 + (D / 64) * (4096 / 64) + (D / 64) * (D / 64)) % 4 == 0, "prologue items per claim");
static_assert((size_t)M * D * 2 <= 129 * MiB && (size_t)M * FF * 2 <= (644 - 289) * MiB, "ws map");
constexpr int LDS_BYTES = 147456;

#define LAS __attribute__((address_space(3)))
typedef unsigned short bf16;
typedef float f32x4 __attribute__((ext_vector_type(4)));
typedef float f32x2 __attribute__((ext_vector_type(2)));
typedef unsigned u32x4 __attribute__((ext_vector_type(4)));
typedef unsigned u32x2 __attribute__((ext_vector_type(2)));

__device__ __forceinline__ unsigned f2bf(float f) { unsigned u = __builtin_bit_cast(unsigned, f); return (u + 0x7fffu + ((u >> 16) & 1u)) >> 16; }
__device__ __forceinline__ unsigned pk2(float lo, float hi) { return f2bf(lo) | (f2bf(hi) << 16); }
__device__ __forceinline__ float bflo(unsigned w) { return __builtin_bit_cast(float, w << 16); }
__device__ __forceinline__ float bfhi(unsigned w) { return __builtin_bit_cast(float, w & 0xffff0000u); }
__device__ __forceinline__ float fsigmoid(float x) { return __builtin_amdgcn_rcpf(1.0f + __builtin_amdgcn_exp2f(-1.4426950408889634f * x)); }
__device__ __forceinline__ float wave_sum(float v) {
#pragma unroll
    for (int o = 1; o < 64; o <<= 1) v += __shfl_xor(v, o);
    return v;
}
__device__ __forceinline__ int fresh_tid() { int t = threadIdx.x; asm volatile("" : "+v"(t)); return t; }
__device__ __forceinline__ int row_batch(int row) { return row < MP ? (row >> 11) : NB_P + ((row - MP) >> 5); }

namespace pg8 {
#define PG8_LAS __attribute__((address_space(3)))
typedef unsigned short bf16_t;
typedef short bf16x8 __attribute__((ext_vector_type(8)));
typedef float f32x4 __attribute__((ext_vector_type(4)));
typedef unsigned u32x4 __attribute__((ext_vector_type(4)));
typedef unsigned u32x2 __attribute__((ext_vector_type(2)));
constexpr int BM = 256, BK = 64, HALF = 128, HTB = HALF * BK * 2  , STAGE_BYTES = 8 * HTB, NXCD = 8, WGM = 8;

__host__ __device__ __forceinline__ int lds_byte(int r, int c) { const int st = (r >> 4) * 2 + (c >> 5), rr = r & 15, cc = c & 31, ob = rr * 64 + cc * 2; return st * 1024 + (ob ^ (((ob >> 9) & 1) << 5)); }
__host__ __device__ __forceinline__ void stage_rc(int b, int& R, int& C) { const int st = b / 1024, sb = b % 1024, swz = sb ^ (((sb >> 9) & 1) << 5); R = (st >> 1) * 16 + swz / 64; C = (st & 1) * 32 + (swz % 64) / 2; }
__host__ __device__ __forceinline__ int perm32(int rho) { const int n = rho >> 4, i = rho & 15; return 8 * (i >> 2) + 4 * n + (i & 3); }

struct Unit { int pm, pn, kt0, nkt, slice, nsplit; };
struct Gemm { const bf16_t* A; const bf16_t* Bt; int M, N, K; };

struct StaticOrder {
    int nM, nN, nwg, G, c;
    __host__ __device__ void init(int M, int N, int G_, int c_) { nM = M / BM; nN = N / BM; nwg = nM * nN; G = G_; c = c_; }
    __host__ __device__ bool next(int i, Unit& u) const {
        const long L = (long)i * G + c; if (L >= nwg) return false;
        int wgid = (int)L; { const int q = nwg / NXCD, r = nwg % NXCD, xcd = wgid % NXCD, off = wgid / NXCD; wgid = (xcd < r ? xcd * (q + 1) : r * (q + 1) + (xcd - r) * q) + off; }
        const int nig = WGM * nN, gid = wgid / nig, fm = gid * WGM, gsz = (nM - fm) < WGM ? (nM - fm) : WGM;
        u.pm = fm + ((wgid % nig) % gsz); u.pn = (wgid % nig) / gsz; return true;
    }
    __device__ __forceinline__ void a_ready(const Unit&) const {}
    __device__ __forceinline__ void done(const Unit&) const {}
};

struct MixedOrder {
    int nMp, nN, nwgp, G, c, nsplit, nkt, nks, wgm, rev = 0;
    __host__ __device__ void init(int Mp, int N, int K, int nsplit_, int G_, int c_, int wgm_ = WGM, int bk = BK) { wgm = wgm_; nMp = Mp / BM; nN = N / BM; nwgp = nMp * nN; G = G_; c = c_; nsplit = nsplit_; nkt = K / bk; nks = nkt / nsplit_; }
    __host__ __device__ bool next(int i, Unit& u) const {
        const long L = (long)i * G + c; const bool smp = L >= nwgp; const int j = (int)(L - nwgp);
        if (smp && j >= nN * nsplit) return false;
        int wgid = smp ? 0 : (int)L; { const int q = nwgp / NXCD, r = nwgp % NXCD, xcd = wgid % NXCD, off = wgid / NXCD; wgid = (xcd < r ? xcd * (q + 1) : r * (q + 1) + (xcd - r) * q) + off; }
        const int nig = wgm * nN, gid = wgid / nig, fm = gid * wgm, gsz = (nMp - fm) < wgm ? (nMp - fm) : wgm;
        const int sl = smp ? j % nsplit : 0;
        const int pmp = fm + ((wgid % nig) % gsz);
        u.pm = smp ? nMp : (rev ? nMp - 1 - pmp : pmp); u.pn = smp ? j / nsplit : (wgid % nig) / gsz; u.slice = sl; u.nsplit = smp ? nsplit : 1; u.kt0 = sl * nks; u.nkt = smp ? nks : nkt; return true;
    }
    __device__ __forceinline__ void a_ready(const Unit&) const {}
    __device__ __forceinline__ void done(const Unit&) const {}
};
struct SplitK { float* part; unsigned* cnt; };
__device__ __forceinline__ bool splitk_fixup(f32x4 (&acc)[2][2][4][2], const Unit& u, const SplitK& sk, int wid, int lane_) {
    (void)lane_; const int lane = fresh_tid() & 63;
    typedef unsigned long long u64;
    u64* mine = (u64*)(sk.part + ((size_t)(u.pn * u.nsplit + u.slice) * 8 + wid) * 8192) + lane;
#pragma unroll
    for (int q = 0; q < 32; ++q) { const f32x4 v = acc[q >> 4][(q >> 3) & 1][(q >> 1) & 3][q & 1];
        __hip_atomic_store(mine + (2 * q) * 64, ((u64)__float_as_uint(v[1]) << 32) | __float_as_uint(v[0]), __ATOMIC_RELAXED, __HIP_MEMORY_SCOPE_AGENT);
        __hip_atomic_store(mine + (2 * q + 1) * 64, ((u64)__float_as_uint(v[3]) << 32) | __float_as_uint(v[2]), __ATOMIC_RELAXED, __HIP_MEMORY_SCOPE_AGENT); }
    asm volatile("s_waitcnt vmcnt(0)" ::: "memory");
    unsigned old = 0; if (lane == 0) old = __hip_atomic_fetch_add(sk.cnt + u.pn * 8 + wid, 1u, __ATOMIC_RELAXED, __HIP_MEMORY_SCOPE_AGENT);
    old = (unsigned)__builtin_amdgcn_readfirstlane((int)old);
    if ((old % (unsigned)u.nsplit) != (unsigned)(u.nsplit - 1)) return false;
#pragma unroll
    for (int q = 0; q < 32; ++q) acc[q >> 4][(q >> 3) & 1][(q >> 1) & 3][q & 1] = (f32x4){0.f, 0.f, 0.f, 0.f};
    for (int sl = 0; sl < u.nsplit; ++sl) { u64* p = (u64*)(sk.part + ((size_t)(u.pn * u.nsplit + sl) * 8 + wid) * 8192) + lane;
#pragma unroll
        for (int q = 0; q < 32; ++q) { const u64 a = __hip_atomic_load(p + (2 * q) * 64, __ATOMIC_RELAXED, __HIP_MEMORY_SCOPE_AGENT), b = __hip_atomic_load(p + (2 * q + 1) * 64, __ATOMIC_RELAXED, __HIP_MEMORY_SCOPE_AGENT);
            f32x4& d = acc[q >> 4][(q >> 3) & 1][(q >> 1) & 3][q & 1];
            d[0] += __uint_as_float((unsigned)a); d[1] += __uint_as_float((unsigned)(a >> 32)); d[2] += __uint_as_float((unsigned)b); d[3] += __uint_as_float((unsigned)(b >> 32)); } }
    return true;
}

__device__ __forceinline__ unsigned cvt_pk_bf16(float lo, float hi) { unsigned r; asm volatile("v_cvt_pk_bf16_f32 %0, %1, %2" : "=v"(r) : "v"(lo), "v"(hi)); return r; }

__device__ __forceinline__ float silu_mul(float g, float u) { return g * __builtin_amdgcn_rcpf(1.0f + __builtin_amdgcn_exp2f(-1.4426950408889634f * g)) * u; }

constexpr float ACT_SCALE = 4.0f, WDN_SCALE = 64.0f, H8_SCALE = 4.0f;
constexpr float WI8_CLAMP = 0.1325825214724777f  , WI8_Q = 127.0f / WI8_CLAMP, WI8_DQ = WI8_CLAMP / 127.0f;
__device__ __forceinline__ unsigned pk4_fp8(float a, float b, float c, float d) {
    a = __builtin_fminf(__builtin_fmaxf(a, -448.f), 448.f); b = __builtin_fminf(__builtin_fmaxf(b, -448.f), 448.f); c = __builtin_fminf(__builtin_fmaxf(c, -448.f), 448.f); d = __builtin_fminf(__builtin_fmaxf(d, -448.f), 448.f);
    int w = __builtin_amdgcn_cvt_pk_fp8_f32(a, b, 0, false); w = __builtin_amdgcn_cvt_pk_fp8_f32(c, d, w, true); return (unsigned)w; }
struct EpiSwiGLU {
    static constexpr bool PERM = true, AFTER_DRAIN = false, HAS_PRE = true;
    unsigned char* O; float inv; const float* rs;
    __device__ __forceinline__ void pre(const Unit& u, int wr, float (&p)[8]) const {
        const int fr = fresh_tid() & 15, row0 = u.pm * BM + wr * 64 + fr;
#pragma unroll
        for (int i = 0; i < 8; ++i) p[i] = rs[row0 + (i >> 2) * HALF + (i & 3) * 16];
    }
    __device__ __forceinline__ void operator()(const f32x4 (&acc)[2][2][4][2], const Unit& u, int wr, int wc, int fr_, int fq_, const float (&pre_)[8]) const {
        (void)fr_; (void)fq_; const int l_ = fresh_tid() & 63, fr = l_ & 15, fq = l_ >> 4;
        const int row0 = u.pm * BM + wr * 64 + fr, col0 = u.pn * HALF + wc * 32 + 8 * fq;
#pragma unroll
        for (int ai = 0; ai < 2; ++ai)
#pragma unroll
            for (int m = 0; m < 4; ++m) { unsigned char* rowp = O + (size_t)(row0 + ai * HALF + m * 16) * FF + col0; const float iv = inv * pre_[ai * 4 + m];
                const f32x2 ivn = (f32x2){-1.4426950408889634f * iv, -1.4426950408889634f * iv}, c2 = (f32x2){ACT_SCALE * iv * iv, ACT_SCALE * iv * iv};
                unsigned wq[2];
#pragma unroll
                for (int n = 0; n < 2; ++n) { const f32x4 ag4 = acc[ai][0][m][n], au4 = acc[ai][1][m][n]; float o[4];
#pragma unroll
                    for (int h = 0; h < 2; ++h) { const f32x2 ag = (f32x2){ag4[2 * h], ag4[2 * h + 1]}, au = (f32x2){au4[2 * h], au4[2 * h + 1]};
                        const f32x2 t = ag * ivn; f32x2 e; e.x = __builtin_amdgcn_exp2f(t.x); e.y = __builtin_amdgcn_exp2f(t.y);
                        const f32x2 d = e + 1.0f; f32x2 r; r.x = __builtin_amdgcn_rcpf(d.x); r.y = __builtin_amdgcn_rcpf(d.y);
                        const f32x2 q = (ag * au) * (r * c2); o[2 * h] = q.x; o[2 * h + 1] = q.y; }
                    wq[n] = pk4_fp8(o[0], o[1], o[2], o[3]); }
                u32x2 w; w.x = wq[0]; w.y = wq[1];
                *(u32x2*)rowp = w; }
    }
};
template <bool IN_F32> struct EpiResT {
    static constexpr bool PERM = false, AFTER_DRAIN = false, HAS_PRE = false;
    const void* xin_p; const void* xin_s; bf16_t* out; const float* gate; float coef;
    __device__ __forceinline__ void operator()(const f32x4 (&acc)[2][2][4][2], const Unit& u, int wr, int wc, int fr_, int fq_) const {
        (void)fr_; (void)fq_; const int l_ = fresh_tid() & 63, fr = l_ & 15, fq = l_ >> 4;
        const int col0 = u.pn * BM + wc * 32 + 4 * fq;
        const bool prm = u.pm < MP / BM;
#pragma unroll
        for (int ai = 0; ai < 2; ++ai)
#pragma unroll
            for (int m = 0; m < 4; ++m) {
                const int rl = ai * HALF + wr * 64 + m * 16 + fr, row = u.pm * BM + rl;
                const int b = prm ? (u.pm >> 3) : NB_P + (rl >> 5);
                const size_t xoff = (prm ? (size_t)row * D : (size_t)(row - MP) * D) + col0;
                const float* gr = gate + (size_t)b * NMOD + col0;
                bf16_t* orow = out + (size_t)row * D + col0;
#pragma unroll
                for (int bj = 0; bj < 2; ++bj)
#pragma unroll
                    for (int n = 0; n < 2; ++n) { f32x4 xv;
                        if (IN_F32) xv = *(const f32x4*)((const float*)(prm ? xin_p : xin_s) + xoff + bj * HALF + n * 16);
                        else { const u32x2 w = *(const u32x2*)((const bf16_t*)(prm ? xin_p : xin_s) + xoff + bj * HALF + n * 16); xv = (f32x4){bflo(w.x), bfhi(w.x), bflo(w.y), bfhi(w.y)}; }
                        const f32x4 gv = *(const f32x4*)(gr + bj * HALF + n * 16);
                        const f32x4 r = xv + (gv * coef) * acc[ai][bj][m][n];
                        u32x2 o; o.x = cvt_pk_bf16(r[0], r[1]); o.y = cvt_pk_bf16(r[2], r[3]); *(u32x2*)(orow + bj * HALF + n * 16) = o; }
                asm volatile("" ::: "memory"); }
    }
};
struct EpiWin {
    static constexpr bool PERM = true, AFTER_DRAIN = false, HAS_PRE = false;
    bf16_t* UV; bf16_t* GLU; bf16_t* GLUS; float* out_cp; float* out_cs;
    __device__ __forceinline__ void operator()(const f32x4 (&acc)[2][2][4][2], const Unit& u, int wr, int wc, int fr_, int fq_) const {
        (void)fr_; (void)fq_; const int l_ = fresh_tid() & 63, fr = l_ & 15, fq = l_ >> 4;
        if (u.pn < 8) {
            const int row0 = u.pm * BM + wr * 64 + fr, col0 = u.pn * BM + wc * 32 + 8 * fq;
#pragma unroll
            for (int ai = 0; ai < 2; ++ai)
#pragma unroll
                for (int m = 0; m < 4; ++m) { bf16_t* rowp = UV + (size_t)(row0 + ai * HALF + m * 16) * 2048 + col0;
#pragma unroll
                    for (int bj = 0; bj < 2; ++bj) { const f32x4 v0 = acc[ai][bj][m][0], v1 = acc[ai][bj][m][1];
                        u32x4 w; w.x = cvt_pk_bf16(v0[0], v0[1]); w.y = cvt_pk_bf16(v0[2], v0[3]); w.z = cvt_pk_bf16(v1[0], v1[1]); w.w = cvt_pk_bf16(v1[2], v1[3]);
                        *(u32x4*)(rowp + bj * HALF) = w; } }
        } else {
            const int ch0 = (u.pn - 8) * HALF + wc * 32 + 8 * fq;
            const bool prm = u.pm < MP / BM;
#pragma unroll
            for (int ai = 0; ai < 2; ++ai)
#pragma unroll
                for (int m = 0; m < 4; ++m) {
                    const int rl = ai * HALF + wr * 64 + m * 16 + fr, row = u.pm * BM + rl;
                    const f32x4 a0 = acc[ai][0][m][0], a1 = acc[ai][0][m][1], b0 = acc[ai][1][m][0], b1 = acc[ai][1][m][1];
                    f32x4 g0, g1;
#pragma unroll
                    for (int j = 0; j < 4; ++j) { g0[j] = a0[j] * fsigmoid(b0[j]); g1[j] = a1[j] * fsigmoid(b1[j]); }
                    u32x4 w; w.x = cvt_pk_bf16(g0[0], g0[1]); w.y = cvt_pk_bf16(g0[2], g0[3]); w.z = cvt_pk_bf16(g1[0], g1[1]); w.w = cvt_pk_bf16(g1[2], g1[3]);
                    *(u32x4*)(prm ? GLU + (size_t)row * DB + ch0 : GLUS + ((size_t)(rl >> 5) * 62 + 30 + (rl & 31)) * DB + ch0) = w;
                    float* so = nullptr;
                    if (prm) { const int t = ((u.pm & 7) << 8) + rl; if (t >= SEQ - 30) so = out_cp + ((size_t)(u.pm >> 3) * 30 + (t - (SEQ - 30))) * DB + ch0; }
                    else { const int tl = rl & 31; if (tl >= 2) so = out_cs + ((size_t)(rl >> 5) * 30 + (tl - 2)) * DB + ch0; }
                    if (so) { *(f32x4*)so = g0; *(f32x4*)(so + 4) = g1; }
                }
        }
    }
};
template <class Epi, class Sched, bool ALIGN_EPI = false, bool SP2 = false, bool FP8 = false, bool I8 = false>
__device__ __forceinline__ void gemm_phase(PG8_LAS unsigned char* lds, const Gemm g, const Sched& S, const Epi& E, const SplitK sk) {
    const int tid = fresh_tid(), wid = __builtin_amdgcn_readfirstlane(tid >> 6), lane = tid & 63, wr = wid >> 2, wc = wid & 3, fr = lane & 15, fq = lane >> 4;
    const int K = g.K, pitch = (FP8 || I8) ? K : 2 * K;
    unsigned voffA[2], voffB[2];
#pragma unroll
    for (int i = 0; i < 2; ++i) { int R, C; stage_rc(tid * 16 + i * 8192, R, C); const int Rb = Epi::PERM ? ((R & ~31) + perm32(R & 31)) : R;
        voffA[i] = (unsigned)(R * pitch + C * 2); voffB[i] = (unsigned)(Rb * pitch + C * 2); }
    const size_t kstep = (size_t)(BK * 2);
    const size_t hstep = (size_t)HALF * pitch;
    const size_t tstep = 2 * hstep;
    const unsigned ldsw = (unsigned)wid * 1024u;
    const int aoff = lds_byte(wr * 64 + fr, fq * 8), boff = lds_byte(wc * 32 + fr, fq * 8);
#define PG8_SA(b, h) (((b) * 2 + (h)) * HTB)
#define PG8_SB(b, h) ((4 + (b) * 2 + (h)) * HTB)
#define PG8_STAGE(bufoff, gbase, voff) do { _Pragma("unroll") for (int _i = 0; _i < 2; ++_i) \
        __builtin_amdgcn_global_load_lds((const unsigned*)((const char*)(gbase) + (voff)[_i]), (PG8_LAS unsigned*)(lds + (bufoff) + ldsw + _i * 8192), 16, 0, 0); } while (0)
#define PG8_LD8(addr) __builtin_shufflevector(*(const PG8_LAS i32x4_*)(addr), *(const PG8_LAS i32x4_*)((addr) + 1024), 0, 1, 2, 3, 4, 5, 6, 7)
#define PG8_LDA(dst, b, h) do { if constexpr (FP8) { _Pragma("unroll") for (int m = 0; m < 4; ++m) dst##8[m] = PG8_LD8(lds + PG8_SA(b, h) + aoff + m * 2048); } \
        else { _Pragma("unroll") for (int m = 0; m < 4; ++m) _Pragma("unroll") for (int k = 0; k < 2; ++k) dst[m][k] = *(const PG8_LAS bf16x8*)(lds + PG8_SA(b, h) + aoff + m * 2048 + k * 1024); } } while (0)
#define PG8_LDB(dst, b, h) do { if constexpr (FP8) { _Pragma("unroll") for (int n = 0; n < 2; ++n) dst##8[n] = PG8_LD8(lds + PG8_SB(b, h) + boff + n * 2048); } \
        else { _Pragma("unroll") for (int n = 0; n < 2; ++n) _Pragma("unroll") for (int k = 0; k < 2; ++k) dst[n][k] = *(const PG8_LAS bf16x8*)(lds + PG8_SB(b, h) + boff + n * 2048 + k * 1024); } } while (0)
#define PG8_MMA(ai, bj, At, Bt) do { __builtin_amdgcn_s_setprio(1); _Pragma("unroll") for (int m = 0; m < 4; ++m) _Pragma("unroll") for (int n = 0; n < 2; ++n) { \
        if constexpr (FP8) asm volatile("v_mfma_f32_16x16x128_f8f6f4 %0, %1, %2, %0" : "+v"(acc[ai][bj][m][n]) : "v"(Bt##8[n]), "v"(At##8[m]));   \
        else if constexpr (I8) { _Pragma("unroll") for (int k = 0; k < 2; ++k) acc[ai][bj][m][n] = __builtin_bit_cast(f32x4, __builtin_amdgcn_mfma_i32_16x16x64_i8(__builtin_bit_cast(i32x4_, Bt[n][k]), __builtin_bit_cast(i32x4_, At[m][k]), __builtin_bit_cast(i32x4_, acc[ai][bj][m][n]), 0, 0, 0)); } \
        else { _Pragma("unroll") for (int k = 0; k < 2; ++k) acc[ai][bj][m][n] = __builtin_amdgcn_mfma_f32_16x16x32_bf16(Bt[n][k], At[m][k], acc[ai][bj][m][n], 0, 0, 0); } } \
        __builtin_amdgcn_s_setprio(0); } while (0)
#define PG8_WAIT_V(n) asm volatile("s_waitcnt vmcnt(" #n ")" ::: "memory")
#define PG8_WAIT_L(n) asm volatile("s_waitcnt lgkmcnt(" #n ")" ::: "memory")
#define PG8_BAR __builtin_amdgcn_s_barrier()
#define PG8_SCHED __builtin_amdgcn_sched_barrier(0)
    Unit cur, nxt; int ui = 0;
    if (!S.next(0, cur)) return;
    f32x4 acc[2][2][4][2];
#pragma unroll
    for (int a = 0; a < 2; ++a)
#pragma unroll
        for (int b = 0; b < 2; ++b)
#pragma unroll
            for (int m = 0; m < 4; ++m)
#pragma unroll
                for (int n = 0; n < 2; ++n) acc[a][b][m][n] = (f32x4){0.f, 0.f, 0.f, 0.f};
    bf16x8 At[4][2], B0[2][2], B1[2][2];
    typedef int i32x4_ __attribute__((ext_vector_type(4))); typedef int i32x8_ __attribute__((ext_vector_type(8)));
    i32x8_ At8[4], B08[2], B18[2];
    const char* cA = (const char*)g.A + (size_t)cur.pm * tstep + (size_t)cur.kt0 * kstep; const char* cB = (const char*)g.Bt + (size_t)cur.pn * tstep + (size_t)cur.kt0 * kstep;
    S.a_ready(cur);
    if constexpr (SP2) {
        PG8_STAGE(PG8_SB(0, 0), cB, voffB); PG8_STAGE(PG8_SB(0, 1), cB + hstep, voffB); PG8_STAGE(PG8_SA(0, 0), cA, voffA); PG8_STAGE(PG8_SA(0, 1), cA + hstep, voffA);
        if (wr == 1) PG8_BAR;
        PG8_WAIT_V(2); PG8_BAR;
        PG8_STAGE(PG8_SB(1, 0), cB + kstep, voffB); PG8_STAGE(PG8_SA(1, 0), cA + kstep, voffA); PG8_STAGE(PG8_SB(1, 1), cB + hstep + kstep, voffB);
        PG8_WAIT_V(6); PG8_BAR;
    } else {
        PG8_STAGE(PG8_SB(0, 0), cB, voffB); PG8_STAGE(PG8_SA(0, 0), cA, voffA); PG8_STAGE(PG8_SB(0, 1), cB + hstep, voffB); PG8_STAGE(PG8_SA(0, 1), cA + hstep, voffA);
        if (wr == 1) PG8_BAR;
        PG8_WAIT_V(4); PG8_BAR;
        PG8_STAGE(PG8_SB(1, 0), cB + kstep, voffB); PG8_STAGE(PG8_SA(1, 0), cA + kstep, voffA); PG8_STAGE(PG8_SB(1, 1), cB + hstep + kstep, voffB);
        PG8_WAIT_V(6); PG8_BAR;
    }
    float epre[8];
    for (;;) {
        if constexpr (Epi::HAS_PRE) E.pre(cur, wr, epre);
        const bool has_next = S.next(ui + 1, nxt);
        const char* nA = has_next ? (const char*)g.A + (size_t)nxt.pm * tstep + (size_t)nxt.kt0 * kstep : cA; const char* nB = has_next ? (const char*)g.Bt + (size_t)nxt.pn * tstep + (size_t)nxt.kt0 * kstep : cB;
        const int nt = cur.nkt;
        for (int t = 0; t < nt; t += 2) {
            const bool last = (t == nt - 2);
            const char* a1 = cA + (size_t)(t + 1) * kstep;
            const char* a2 = last ? nA : cA + (size_t)(t + 2) * kstep; const char* b2 = last ? nB : cB + (size_t)(t + 2) * kstep;
            const char* a3 = a2 + kstep; const char* b3 = b2 + kstep;
            if (last && has_next) S.a_ready(nxt);
            if constexpr (SP2) {
            PG8_LDB(B0, 0, 0); PG8_LDB(B1, 0, 1); PG8_SCHED; PG8_LDA(At, 0, 0); PG8_STAGE(PG8_SA(1, 1), a1 + hstep, voffA);
            PG8_WAIT_V(8); PG8_WAIT_L(0); PG8_BAR; PG8_MMA(0, 0, At, B0); PG8_MMA(0, 1, At, B1); PG8_BAR; PG8_SCHED;
            PG8_LDA(At, 0, 1); PG8_STAGE(PG8_SB(0, 0), b2, voffB); PG8_STAGE(PG8_SB(0, 1), b2 + hstep, voffB); PG8_STAGE(PG8_SA(0, 0), a2, voffA);
            PG8_WAIT_V(8); PG8_WAIT_L(0); PG8_BAR; PG8_MMA(1, 0, At, B0); PG8_MMA(1, 1, At, B1); PG8_BAR; PG8_SCHED;
            PG8_LDB(B0, 1, 0); PG8_LDB(B1, 1, 1); PG8_SCHED; PG8_LDA(At, 1, 0); PG8_STAGE(PG8_SA(0, 1), a2 + hstep, voffA);
            PG8_WAIT_V(8); PG8_WAIT_L(0); PG8_BAR; PG8_MMA(0, 0, At, B0); PG8_MMA(0, 1, At, B1); PG8_BAR; PG8_SCHED;
            PG8_LDA(At, 1, 1); PG8_STAGE(PG8_SB(1, 0), b3, voffB); PG8_STAGE(PG8_SB(1, 1), b3 + hstep, voffB); PG8_STAGE(PG8_SA(1, 0), a3, voffA);
            PG8_WAIT_V(8); PG8_WAIT_L(0); PG8_BAR; PG8_MMA(1, 0, At, B0); PG8_MMA(1, 1, At, B1); PG8_BAR; PG8_SCHED;
            } else {
            PG8_LDB(B0, 0, 0); PG8_SCHED; PG8_LDA(At, 0, 0); PG8_STAGE(PG8_SA(1, 1), a1 + hstep, voffA);
            PG8_WAIT_L(8); PG8_BAR; PG8_WAIT_L(0); PG8_MMA(0, 0, At, B0); PG8_BAR; PG8_SCHED;
            PG8_LDB(B1, 0, 1); PG8_STAGE(PG8_SB(0, 0), b2, voffB);
            PG8_BAR; PG8_WAIT_L(0); PG8_MMA(0, 1, At, B1); PG8_BAR;
            PG8_LDA(At, 0, 1); PG8_STAGE(PG8_SA(0, 0), a2, voffA);
            PG8_BAR; PG8_WAIT_L(0); PG8_MMA(1, 0, At, B0); PG8_BAR; PG8_SCHED;
            PG8_STAGE(PG8_SB(0, 1), b2 + hstep, voffB);
            PG8_WAIT_V(6); PG8_BAR; PG8_MMA(1, 1, At, B1); PG8_BAR;
            PG8_LDB(B0, 1, 0); PG8_SCHED; PG8_LDA(At, 1, 0); PG8_STAGE(PG8_SA(0, 1), a2 + hstep, voffA);
            PG8_WAIT_L(8); PG8_BAR; PG8_WAIT_L(0); PG8_MMA(0, 0, At, B0); PG8_BAR; PG8_SCHED;
            PG8_LDB(B1, 1, 1); PG8_STAGE(PG8_SB(1, 0), b3, voffB);
            PG8_BAR; PG8_WAIT_L(0); PG8_MMA(0, 1, At, B1); PG8_BAR;
            PG8_LDA(At, 1, 1); PG8_STAGE(PG8_SA(1, 0), a3, voffA);
            PG8_BAR; PG8_WAIT_L(0); PG8_MMA(1, 0, At, B0); PG8_BAR; PG8_SCHED;
            PG8_STAGE(PG8_SB(1, 1), b3 + hstep, voffB);
            PG8_WAIT_V(6); PG8_BAR; PG8_MMA(1, 1, At, B1); PG8_BAR;
            }
        }
        if constexpr (I8) {
            _Pragma("unroll") for (int a_ = 0; a_ < 2; ++a_) _Pragma("unroll") for (int b_ = 0; b_ < 2; ++b_) _Pragma("unroll") for (int m_ = 0; m_ < 4; ++m_) _Pragma("unroll") for (int n_ = 0; n_ < 2; ++n_) {
                const i32x4_ iv_ = __builtin_bit_cast(i32x4_, acc[a_][b_][m_][n_]); acc[a_][b_][m_][n_] = (f32x4){(float)iv_[0], (float)iv_[1], (float)iv_[2], (float)iv_[3]}; } }
        if constexpr (FP8) asm volatile("s_nop 15\n\ts_nop 15\n\ts_nop 15" ::: "memory");
        if constexpr (ALIGN_EPI) { if (wr == 0) PG8_BAR; }
        if constexpr (!Epi::AFTER_DRAIN) { bool do_epi = true; if (cur.nsplit > 1) do_epi = splitk_fixup(acc, cur, sk, wid, lane); if (do_epi) { if constexpr (Epi::HAS_PRE) E(acc, cur, wr, wc, fr, fq, epre); else E(acc, cur, wr, wc, fr, fq); } S.done(cur); }
        if (!has_next) break;
#pragma unroll
        for (int a = 0; a < 2; ++a)
#pragma unroll
            for (int b = 0; b < 2; ++b)
#pragma unroll
                for (int m = 0; m < 4; ++m)
#pragma unroll
                    for (int n = 0; n < 2; ++n) acc[a][b][m][n] = (f32x4){0.f, 0.f, 0.f, 0.f};
        cur = nxt; cA = nA; cB = nB; ++ui;
        if constexpr (ALIGN_EPI) { if (wr == 1) PG8_BAR; }
    }
    PG8_WAIT_V(0);
    if constexpr (!ALIGN_EPI) { if (wr == 0) PG8_BAR; }
    PG8_BAR;
    if constexpr (Epi::AFTER_DRAIN) { E.fused(acc, cur, wr, wc, fr, fq, lds, wid, lane); S.done(cur); }
#undef PG8_SA
#undef PG8_SB
#undef PG8_STAGE
#undef PG8_LDA
#undef PG8_LD8
#undef PG8_LDB
#undef PG8_MMA
#undef PG8_WAIT_V
#undef PG8_WAIT_L
#undef PG8_BAR
#undef PG8_SCHED
}
}

struct Args { const float* in[26]; float* out; unsigned char* ws; int ph_lo, ph_hi; };
constexpr int NPH = 12;
typedef short bf16x8 __attribute__((ext_vector_type(8)));

__device__ __forceinline__ void transpose_item(const float* W, int K, int N, bf16* WT, int k0, int n0s, int n0d, LAS float* scr, int lane) {
    const int kr = lane >> 4, n4 = (lane & 15) * 4;
    f32x4 v[16];
#pragma unroll
    for (int i = 0; i < 16; ++i) v[i] = *(const f32x4*)(W + (size_t)(k0 + 4 * i + kr) * N + n0s + n4);
#pragma unroll
    for (int i = 0; i < 16; ++i) { LAS float* d = scr + (4 * i + kr) * 65 + n4; d[0] = v[i][0]; d[1] = v[i][1]; d[2] = v[i][2]; d[3] = v[i][3]; }
    asm volatile("s_waitcnt lgkmcnt(0)" ::: "memory");
    const int c = lane & 7;
#pragma unroll
    for (int j = 0; j < 8; ++j) { const int n = (lane >> 3) + 8 * j; const LAS float* sp = scr + (8 * c) * 65 + n;
        u32x4 o; o.x = pk2(sp[0 * 65], sp[1 * 65]); o.y = pk2(sp[2 * 65], sp[3 * 65]); o.z = pk2(sp[4 * 65], sp[5 * 65]); o.w = pk2(sp[6 * 65], sp[7 * 65]);
        *(u32x4*)(WT + (size_t)(n0d + n) * K + k0 + 8 * c) = o; }
    asm volatile("s_waitcnt lgkmcnt(0)" ::: "memory");
}
__device__ __forceinline__ void transpose_item_fp8(const float* W, int K, int N, unsigned char* WT, int k0, int n0s, int n0d, LAS float* scr, int lane) {
    const int kr = lane >> 4, n4 = (lane & 15) * 4;
    f32x4 v[16];
#pragma unroll
    for (int i = 0; i < 16; ++i) v[i] = *(const f32x4*)(W + (size_t)(k0 + 4 * i + kr) * N + n0s + n4);
#pragma unroll
    for (int i = 0; i < 16; ++i) { LAS float* d = scr + (4 * i + kr) * 65 + n4; d[0] = v[i][0]; d[1] = v[i][1]; d[2] = v[i][2]; d[3] = v[i][3]; }
    asm volatile("s_waitcnt lgkmcnt(0)" ::: "memory");
    const int c = lane & 7;
#pragma unroll
    for (int j = 0; j < 8; ++j) { const int n = (lane >> 3) + 8 * j; const LAS float* sp = scr + (8 * c) * 65 + n;
        u32x2 o; o.x = pg8::pk4_fp8(sp[0 * 65] * pg8::WDN_SCALE, sp[1 * 65] * pg8::WDN_SCALE, sp[2 * 65] * pg8::WDN_SCALE, sp[3 * 65] * pg8::WDN_SCALE);
        o.y = pg8::pk4_fp8(sp[4 * 65] * pg8::WDN_SCALE, sp[5 * 65] * pg8::WDN_SCALE, sp[6 * 65] * pg8::WDN_SCALE, sp[7 * 65] * pg8::WDN_SCALE);
        *(u32x2*)(WT + (size_t)(n0d + n) * K + k0 + 8 * c) = o; }
    asm volatile("s_waitcnt lgkmcnt(0)" ::: "memory");
}
__device__ __forceinline__ unsigned pk4_i8(float a, float b, float c, float d) {
    a = __builtin_fminf(__builtin_fmaxf(a * pg8::WI8_Q, -127.f), 127.f); b = __builtin_fminf(__builtin_fmaxf(b * pg8::WI8_Q, -127.f), 127.f);
    c = __builtin_fminf(__builtin_fmaxf(c * pg8::WI8_Q, -127.f), 127.f); d = __builtin_fminf(__builtin_fmaxf(d * pg8::WI8_Q, -127.f), 127.f);
    return (__float_as_uint(a + 12582912.0f) & 0xffu) | ((__float_as_uint(b + 12582912.0f) & 0xffu) << 8) | ((__float_as_uint(c + 12582912.0f) & 0xffu) << 16) | ((__float_as_uint(d + 12582912.0f) & 0xffu) << 24); }
__device__ __forceinline__ void transpose_item_i8(const float* W, int K, int N, unsigned char* WT, int k0, int n0s, int n0d, LAS float* scr, int lane) {
    const int kr = lane >> 4, n4 = (lane & 15) * 4;
    f32x4 v[16];
#pragma unroll
    for (int i = 0; i < 16; ++i) v[i] = *(const f32x4*)(W + (size_t)(k0 + 4 * i + kr) * N + n0s + n4);
#pragma unroll
    for (int i = 0; i < 16; ++i) { LAS float* d = scr + (4 * i + kr) * 65 + n4; d[0] = v[i][0]; d[1] = v[i][1]; d[2] = v[i][2]; d[3] = v[i][3]; }
    asm volatile("s_waitcnt lgkmcnt(0)" ::: "memory");
    const int c = lane & 7;
#pragma unroll
    for (int j = 0; j < 8; ++j) { const int n = (lane >> 3) + 8 * j; const LAS float* sp = scr + (8 * c) * 65 + n;
        u32x2 o; o.x = pk4_i8(sp[0 * 65], sp[1 * 65], sp[2 * 65], sp[3 * 65]); o.y = pk4_i8(sp[4 * 65], sp[5 * 65], sp[6 * 65], sp[7 * 65]);
        *(u32x2*)(WT + (size_t)(n0d + n) * K + k0 + 8 * c) = o; }
    asm volatile("s_waitcnt lgkmcnt(0)" ::: "memory");
}
__device__ __forceinline__ int map_up(int n) { const int pn = n >> 8, s = (n >> 7) & 1, j = n & 127; return s * FF + 128 * pn + j; }
__device__ __forceinline__ int map_win(int n) { if (n < 2048) return n; const int t = n - 2048, q = t >> 8, s = (t >> 7) & 1, j = t & 127; return 2048 + 1024 * s + 128 * q + j; }

__device__ __forceinline__ void mod_item(const Args& a, LAS unsigned char* lds, int cb, int tid, int wave, int lane) {
    const float* cp = a.in[3]; const float* cs = a.in[4]; const float* w_ada = a.in[5]; const float* b_ada = a.in[6];
    float* mod = (float*)(a.ws + WS_MOD);
    LAS float* sl = (LAS float*)lds;
    f32x2 acc[NBT];
#pragma unroll
    for (int b = 0; b < NBT; ++b) acc[b] = (f32x2){0.f, 0.f};
    for (int kc = 0; kc < D; kc += 512) {
#pragma unroll
        for (int b = 0; b < NBT; ++b) { const float c = b < NB_P ? cp[b * D + kc + tid] : cs[(b - NB_P) * D + kc + tid]; sl[tid * NBT + b] = c * fsigmoid(c); }
        __syncthreads();
        const float* wp = w_ada + (size_t)(kc + 64 * wave) * NMOD + 128 * cb + 2 * lane;
#pragma unroll 1
        for (int k8 = 0; k8 < 64; k8 += 16) {
            f32x2 wv[16];
#pragma unroll
            for (int u = 0; u < 16; ++u) wv[u] = __builtin_nontemporal_load((const f32x2*)(wp + (size_t)(k8 + u) * NMOD));
#pragma unroll
            for (int u = 0; u < 16; ++u) {
                const LAS f32x4* sp = (const LAS f32x4*)(sl + (64 * wave + k8 + u) * NBT);
#pragma unroll
                for (int q = 0; q < NBT / 4; ++q) { const f32x4 s4 = sp[q]; acc[4 * q + 0] += s4[0] * wv[u]; acc[4 * q + 1] += s4[1] * wv[u]; acc[4 * q + 2] += s4[2] * wv[u]; acc[4 * q + 3] += s4[3] * wv[u]; }
            }
        }
        __syncthreads();
    }
    LAS float* red = (LAS float*)lds;
#pragma unroll
    for (int b = 0; b < NBT; ++b) *(LAS f32x2*)(red + (wave * NBT + b) * 128 + 2 * lane) = acc[b];
    __syncthreads();
#pragma unroll
    for (int i = 0; i < 6; ++i) { const int o = tid + 512 * i, b = o >> 7, col = o & 127; float s = b_ada[128 * cb + col];
#pragma unroll
        for (int w = 0; w < 8; ++w) s += red[(w * NBT + b) * 128 + col];
        mod[(size_t)b * NMOD + 128 * cb + col] = s; }
    __syncthreads();
}

__device__ __forceinline__ void p0_prologue(const Args& a, LAS unsigned char* lds, int G, int bid, int tid, int wave, int lane) {
    for (int cb = bid; cb < NMOD / 128; cb += G) mod_item(a, lds, cb, tid, wave, lane);
    { const float* w_s = a.in[13]; bf16* wsm = (bf16*)(a.ws + WS_WSM);
      for (int i = bid * 512 + tid; i < NG * 128 * 128; i += G * 512) { const int ii = (i >> 7) & 127, jj = i & 127; wsm[i] = (bf16)(jj <= ii ? f2bf(w_s[i]) : 0u); } }
    { const float* cache = a.in[2]; bf16* gs = (bf16*)(a.ws + WS_GLUS);
      for (int i = bid * 512 + tid; i < NB_S * 30 * DB; i += G * 512) { const int bs = i / (30 * DB), rem = i - bs * 30 * DB; gs[(size_t)bs * 62 * DB + rem] = (bf16)f2bf(cache[i]); } }
    LAS float* scr = (LAS float*)(lds + wave * 16640);
    unsigned* ctr = (unsigned*)(a.ws + WS_CTL);
    constexpr int I_UP = (D / 64) * (2 * FF / 64), I_DN = (FF / 64) * (D / 64), I_IN = (D / 64) * (4096 / 64), I_OUT = (D / 64) * (D / 64);
    constexpr int NITEMS = 2 * I_UP + 2 * I_DN + I_IN + I_OUT;
    struct Item { const float* W; unsigned char* WT; int K, N, k0, n0s, n0d, kind; };
    auto decode = [&](int it) -> Item {
        Item t; int r = it;
        if (r < 2 * I_UP) { const int which = r >= I_UP; r -= which * I_UP; const int nblk = 2 * FF / 64, kb = r / nblk, nb = r % nblk;
            t.W = a.in[which ? 23 : 8]; t.WT = a.ws + (which ? WS_WUP2 : WS_WUP1); t.K = D; t.N = 2 * FF; t.k0 = 64 * kb; t.n0s = map_up(64 * nb); t.n0d = 64 * nb; t.kind = 2; return t; }
        r -= 2 * I_UP;
        if (r < 2 * I_DN) { const int which = r >= I_DN; r -= which * I_DN; const int nblk = D / 64, kb = r / nblk, nb = r % nblk;
            t.W = a.in[which ? 24 : 9]; t.WT = a.ws + (which ? WS_WDN2 : WS_WDN1); t.K = FF; t.N = D; t.k0 = 64 * kb; t.n0s = 64 * nb; t.n0d = 64 * nb; t.kind = 1; return t; }
        r -= 2 * I_DN;
        if (r < I_IN) { const int nblk = 4096 / 64, kb = r / nblk, nb = r % nblk;
            t.W = a.in[11]; t.WT = a.ws + WS_WIN; t.K = D; t.N = 4096; t.k0 = 64 * kb; t.n0s = map_win(64 * nb); t.n0d = 64 * nb; t.kind = 0; return t; }
        r -= I_IN;
        { const int nblk = D / 64, kb = r / nblk, nb = r % nblk; t.W = a.in[21]; t.WT = a.ws + WS_WOUT; t.K = D; t.N = D; t.k0 = 64 * kb; t.n0s = 64 * nb; t.n0d = 64 * nb; t.kind = 0; return t; }
    };
    const int kr = lane >> 4, n4 = (lane & 15) * 4, c8 = lane & 7;
    auto issue = [&](const Item& t, f32x4 (&v)[16]) {
#pragma unroll
        for (int i = 0; i < 16; ++i) v[i] = __builtin_nontemporal_load((const f32x4*)(t.W + (size_t)(t.k0 + 4 * i + kr) * t.N + t.n0s + n4)); };
    auto finish = [&](const Item& t, const f32x4 (&v)[16]) {
#pragma unroll
        for (int i = 0; i < 16; ++i) { LAS float* d = scr + (4 * i + kr) * 65 + n4; d[0] = v[i][0]; d[1] = v[i][1]; d[2] = v[i][2]; d[3] = v[i][3]; }
        asm volatile("s_waitcnt lgkmcnt(0)" ::: "memory");
#pragma unroll
        for (int j = 0; j < 8; ++j) { const int n = (lane >> 3) + 8 * j; const LAS float* sp = scr + (8 * c8) * 65 + n;
            const float e0 = sp[0 * 65], e1 = sp[1 * 65], e2 = sp[2 * 65], e3 = sp[3 * 65], e4 = sp[4 * 65], e5 = sp[5 * 65], e6 = sp[6 * 65], e7 = sp[7 * 65];
            if (t.kind == 0) { u32x4 o; o.x = pk2(e0, e1); o.y = pk2(e2, e3); o.z = pk2(e4, e5); o.w = pk2(e6, e7); *(u32x4*)((bf16*)t.WT + (size_t)(t.n0d + n) * t.K + t.k0 + 8 * c8) = o; }
            else { u32x2 o;
                if (t.kind == 1) { o.x = pg8::pk4_fp8(e0 * pg8::WDN_SCALE, e1 * pg8::WDN_SCALE, e2 * pg8::WDN_SCALE, e3 * pg8::WDN_SCALE); o.y = pg8::pk4_fp8(e4 * pg8::WDN_SCALE, e5 * pg8::WDN_SCALE, e6 * pg8::WDN_SCALE, e7 * pg8::WDN_SCALE); }
                else { o.x = pk4_i8(e0, e1, e2, e3); o.y = pk4_i8(e4, e5, e6, e7); }
                *(u32x2*)(t.WT + (size_t)(t.n0d + n) * t.K + t.k0 + 8 * c8) = o; } }
        asm volatile("s_waitcnt lgkmcnt(0)" ::: "memory"); };
    for (;;) {
        int it0 = 0; if (lane == 0) it0 = (int)atomicAdd(ctr, 4u); it0 = __builtin_amdgcn_readfirstlane(it0);
        if (it0 >= NITEMS) break;
        f32x4 va[16], vb[16];
        const Item t0 = decode(it0), t1 = decode(it0 + 1), t2 = decode(it0 + 2), t3 = decode(it0 + 3);
        issue(t0, va); issue(t1, vb);
        finish(t0, va); issue(t2, va);
        finish(t1, vb); issue(t3, vb);
        finish(t2, va);
        finish(t3, vb);
    }
}

template <int MODE  , bool SRC16 = false  >
__device__ __forceinline__ void norm_phase(const void* srcp_, const void* srcs_, const float* g, const float* mod, int sh_off, int sc_off, void* dst, int gw, int ngw, int lane, float* rs = nullptr) {
    for (int it = gw; it < M / 8; it += ngw) {
        const int row0 = it * 8, b = row_batch(row0);
        const float* src = row0 < MP ? (const float*)srcp_ + (size_t)row0 * D : (const float*)srcs_ + (size_t)(row0 - MP) * D;
        const bf16* src16 = row0 < MP ? (const bf16*)srcp_ + (size_t)row0 * D : (const bf16*)srcs_ + (size_t)(row0 - MP) * D; (void)src; (void)src16;
        f32x4 Gv[8], Sv[8];
#pragma unroll
        for (int j = 0; j < 8; ++j) { const int col = 4 * lane + 256 * j; const f32x4 gg = *(const f32x4*)(g + col);
            if (MODE == 1) { Gv[j] = gg; Sv[j] = (f32x4){0.f, 0.f, 0.f, 0.f}; }
            else { const f32x4 sc = *(const f32x4*)(mod + (size_t)b * NMOD + sc_off + col); Gv[j] = gg * (1.0f + sc); Sv[j] = *(const f32x4*)(mod + (size_t)b * NMOD + sh_off + col); } }
#pragma unroll 1
        for (int r4 = 0; r4 < 8; r4 += 4) {
            f32x4 v[4][8];
#pragma unroll
            for (int q = 0; q < 4; ++q) {
                if (SRC16) { const u32x2* xr = (const u32x2*)(src16 + (size_t)(r4 + q) * D) + lane;
#pragma unroll
                    for (int j = 0; j < 8; ++j) { const u32x2 w = xr[64 * j]; v[q][j] = (f32x4){bflo(w.x), bfhi(w.x), bflo(w.y), bfhi(w.y)}; } }
                else { const f32x4* xr = (const f32x4*)(src + (size_t)(r4 + q) * D) + lane;
#pragma unroll
                    for (int j = 0; j < 8; ++j) v[q][j] = __builtin_nontemporal_load(&xr[64 * j]); } }
#pragma unroll
            for (int q = 0; q < 4; ++q) {
                float ss = 0.f;
#pragma unroll
                for (int j = 0; j < 8; ++j) ss += (v[q][j][0] * v[q][j][0] + v[q][j][1] * v[q][j][1]) + (v[q][j][2] * v[q][j][2] + v[q][j][3] * v[q][j][3]);
                const float rs_ = 1.0f / sqrtf(wave_sum(ss) * (1.0f / D) + EPS);
                if (MODE == 1) { f32x4* o = (f32x4*)((float*)dst + (size_t)(row0 + r4 + q) * D) + lane;
#pragma unroll
                    for (int j = 0; j < 8; ++j) __builtin_nontemporal_store((v[q][j] * rs_) * Gv[j], &o[64 * j]); }
                else if (MODE == 3) { unsigned* o = (unsigned*)((unsigned char*)dst + (size_t)(row0 + r4 + q) * D) + lane;
                    f32x4 y[8]; float mx = 0.f;
#pragma unroll
                    for (int j = 0; j < 8; ++j) { y[j] = (v[q][j] * rs_) * Gv[j] + Sv[j]; mx = fmaxf(mx, fmaxf(fmaxf(fabsf(y[j][0]), fabsf(y[j][1])), fmaxf(fabsf(y[j][2]), fabsf(y[j][3])))); }
#pragma unroll
                    for (int off = 1; off < 64; off <<= 1) mx = fmaxf(mx, __shfl_xor(mx, off));
                    mx = fmaxf(mx, 1e-20f); const float qs = 127.0f / mx;
                    if (lane == 0) rs[row0 + r4 + q] = mx * (1.0f / 127.0f);
#pragma unroll
                    for (int j = 0; j < 8; ++j) {
                        const unsigned b0 = __float_as_uint(y[j][0] * qs + 12582912.0f) & 0xffu, b1 = __float_as_uint(y[j][1] * qs + 12582912.0f) & 0xffu,
                                       b2 = __float_as_uint(y[j][2] * qs + 12582912.0f) & 0xffu, b3 = __float_as_uint(y[j][3] * qs + 12582912.0f) & 0xffu;
                        o[64 * j] = b0 | (b1 << 8) | (b2 << 16) | (b3 << 24); } }
                else if (MODE == 2) { unsigned* o = (unsigned*)((unsigned char*)dst + (size_t)(row0 + r4 + q) * D) + lane;
#pragma unroll
                    for (int j = 0; j < 8; ++j) { const f32x4 y = ((v[q][j] * rs_) * Gv[j] + Sv[j]) * pg8::H8_SCALE; o[64 * j] = pg8::pk4_fp8(y[0], y[1], y[2], y[3]); } }
                else { u32x2* o = (u32x2*)((bf16*)dst + (size_t)(row0 + r4 + q) * D) + lane;
#pragma unroll
                    for (int j = 0; j < 8; ++j) { const f32x4 y = (v[q][j] * rs_) * Gv[j] + Sv[j]; u32x2 w; w.x = pk2(y[0], y[1]); w.y = pk2(y[2], y[3]); o[64 * j] = w; } }
            }
        }
    }
}

__device__ __forceinline__ float halving_reduce32(const float (&v)[32], int lane) {
    float a[16], b[8], c4[4], d[2];
    { const bool hi = (lane & 32) != 0;
#pragma unroll
      for (int i = 0; i < 16; ++i) { const float send = hi ? v[i] : v[16 + i], keep = hi ? v[16 + i] : v[i]; a[i] = keep + __shfl_xor(send, 32); } }
    { const bool hi = (lane & 16) != 0;
#pragma unroll
      for (int i = 0; i < 8; ++i) { const float send = hi ? a[i] : a[8 + i], keep = hi ? a[8 + i] : a[i]; b[i] = keep + __shfl_xor(send, 16); } }
    { const bool hi = (lane & 8) != 0;
#pragma unroll
      for (int i = 0; i < 4; ++i) { const float send = hi ? b[i] : b[4 + i], keep = hi ? b[4 + i] : b[i]; c4[i] = keep + __shfl_xor(send, 8); } }
    { const bool hi = (lane & 4) != 0;
#pragma unroll
      for (int i = 0; i < 2; ++i) { const float send = hi ? c4[i] : c4[2 + i], keep = hi ? c4[2 + i] : c4[i]; d[i] = keep + __shfl_xor(send, 4); } }
    float e; { const bool hi = (lane & 2) != 0; const float send = hi ? d[0] : d[1], keep = hi ? d[1] : d[0]; e = keep + __shfl_xor(send, 2); }
    return e + __shfl_xor(e, 1);
}
constexpr int MX_VS = 0, MX_RJ = 65536, MX_PART = 65536 + 256, MX_RED = 65536 + 4096, MX_STAT = 65536 + 8192;
__device__ __forceinline__ void mixer_chunk(const Args& a, LAS unsigned char* lds, int chunkrow0, int nks, int sbs, int pos0c, int tid_, int wave, int lane_, bool doA = true, bool doB = true) {
    int tid = tid_, lane = lane_; asm volatile("" : "+v"(tid), "+v"(lane));
    const bf16* UV = (const bf16*)(a.ws + WS_UV); const bf16* GLU = (const bf16*)(a.ws + WS_GLU); const bf16* WSM = (const bf16*)(a.ws + WS_WSM);
    bf16* YC = (bf16*)(a.ws + WS_H);
    const float* g_v = a.in[12]; const float* b_s = a.in[14]; const float* w_dw = a.in[15]; const float* b_dw = a.in[16]; const float* g_cn = a.in[17]; const float* b_cn = a.in[18];
    const float* g_oa = a.in[19]; const float* g_ob = a.in[20];
    LAS bf16* vs = (LAS bf16*)(lds + MX_VS); LAS float* rj = (LAS float*)(lds + MX_RJ); LAS float* part = (LAS float*)(lds + MX_PART);
    LAS float* red = (LAS float*)(lds + MX_RED); LAS float* stat = (LAS float*)(lds + MX_STAT);
    const int fr0 = lane & 15, fq0 = lane >> 4, g = wave;
    if (doA)
    {
    bf16x8 bfr[3][8];
    u32x4 stg[8];
#pragma unroll
    for (int i = 0; i < 8; ++i) { const int idx = tid + 512 * i, r = idx >> 7, ch = idx & 127; stg[i] = *(const u32x4*)(UV + (size_t)(chunkrow0 + r) * 2048 + 1024 + 8 * ch); }
#pragma unroll
    for (int ks = 0; ks < 4; ++ks) {
        if (ks < nks) {
        const int ib = ks, rowbase = chunkrow0 + 32 * ib;
        int fr = fr0, fq = fq0; asm volatile("" : "+v"(fr), "+v"(fq));
        __syncthreads();
        asm volatile("" : "+v"(tid));
#pragma unroll
        for (int i = 0; i < 8; ++i) { const int idx = tid + 512 * i, r = idx >> 7, ch = idx & 127;
            *(LAS u32x4*)(vs + r * 1024 + ((8 * ch) ^ (((r >> 3) & 3) << 4))) = stg[i]; }
        __syncthreads();
#pragma unroll
        for (int rr = 0; rr < 4; ++rr) { const int r = 4 * wave + rr; const LAS u32x4* p = (const LAS u32x4*)(vs + r * 1024 + lane * 16); float ss = 0.f;
#pragma unroll
            for (int h = 0; h < 2; ++h) { const u32x4 q = p[h];
#pragma unroll
                for (int e = 0; e < 4; ++e) { const float lo = bflo(q[e]), hi = bfhi(q[e]); ss += lo * lo + hi * hi; } }
            ss = wave_sum(ss); if (lane == 0) rj[r] = 1.0f / sqrtf(ss * (1.0f / DA) + EPS); }
        __syncthreads();
        if (sbs >= 0) {
            float* ov = a.out + OUT_VS + (size_t)sbs * SSEQ * DA;
#pragma unroll
            for (int i = 0; i < 8; ++i) { const int idx = tid + 512 * i, r = idx >> 7, ch = idx & 127;
                const u32x4 q = *(const LAS u32x4*)(vs + r * 1024 + ((8 * ch) ^ (((r >> 3) & 3) << 4))); const float rr = rj[r];
                const f32x4 g0 = *(const f32x4*)(g_v + 8 * ch), g1 = *(const f32x4*)(g_v + 8 * ch + 4);
                f32x4 o0, o1; o0[0] = bflo(q[0]) * rr * g0[0]; o0[1] = bfhi(q[0]) * rr * g0[1]; o0[2] = bflo(q[1]) * rr * g0[2]; o0[3] = bfhi(q[1]) * rr * g0[3];
                o1[0] = bflo(q[2]) * rr * g1[0]; o1[1] = bfhi(q[2]) * rr * g1[1]; o1[2] = bflo(q[3]) * rr * g1[2]; o1[3] = bfhi(q[3]) * rr * g1[3];
                *(f32x4*)(ov + (size_t)r * DA + 8 * ch) = o0; *(f32x4*)(ov + (size_t)r * DA + 8 * ch + 4) = o1; }
        }
        f32x4 acc[2][8];
#pragma unroll
        for (int mt = 0; mt < 2; ++mt)
#pragma unroll
            for (int nt = 0; nt < 8; ++nt) acc[mt][nt] = (f32x4){0.f, 0.f, 0.f, 0.f};
        float rjv[8];
#pragma unroll
        for (int jj = 0; jj < 8; ++jj) rjv[jj] = rj[8 * fq + jj];
        { bf16x8 af[2];
#pragma unroll
          for (int mt = 0; mt < 2; ++mt) af[mt] = *(const bf16x8*)(WSM + ((size_t)(g * 128 + 32 * ib + 16 * mt + fr)) * 128 + 32 * ks + 8 * fq);
#pragma unroll
          for (int nt = 0; nt < 8; ++nt) { const int d = g * HD + 16 * nt + fr; const float gvd = g_v[d];
            float f[8];
#pragma unroll
            for (int jj = 0; jj < 8; ++jj) { const unsigned x = vs[(8 * fq + jj) * 1024 + (d ^ (fq << 4))]; f[jj] = __builtin_bit_cast(float, x << 16) * rjv[jj] * gvd; }
            u32x4 bw; bw.x = pk2(f[0], f[1]); bw.y = pk2(f[2], f[3]); bw.z = pk2(f[4], f[5]); bw.w = pk2(f[6], f[7]);
            const bf16x8 bfrag = __builtin_bit_cast(bf16x8, bw);
            if (ks < 3) bfr[ks < 3 ? ks : 0][nt] = bfrag;
#pragma unroll
            for (int mt = 0; mt < 2; ++mt) acc[mt][nt] = __builtin_amdgcn_mfma_f32_16x16x32_bf16(bfrag, af[mt], acc[mt][nt], 0, 0, 0);
            if (nt & 1) asm volatile("" ::: "memory"); } }
#pragma unroll
        for (int k = 0; k < 3; ++k) {
            if (k < ks) { bf16x8 af[2];
#pragma unroll
                for (int mt = 0; mt < 2; ++mt) af[mt] = *(const bf16x8*)(WSM + ((size_t)(g * 128 + 32 * ib + 16 * mt + fr)) * 128 + 32 * k + 8 * fq);
#pragma unroll
                for (int nt = 0; nt < 8; ++nt)
#pragma unroll
                    for (int mt = 0; mt < 2; ++mt) acc[mt][nt] = __builtin_amdgcn_mfma_f32_16x16x32_bf16(bfr[k][nt], af[mt], acc[mt][nt], 0, 0, 0); }
        }
        asm volatile("" ::: "memory");
#pragma unroll
        for (int mt = 0; mt < 2; ++mt) { const float bias = b_s[g * 128 + 32 * ib + 16 * mt + fr]; const int row = rowbase + 16 * mt + fr; float sq = 0.f;
#pragma unroll
            for (int nt = 0; nt < 8; ++nt) { const u32x2 uw = *(const u32x2*)(UV + (size_t)row * 2048 + g * HD + 16 * nt + 4 * fq);
                f32x4 y = acc[mt][nt] + bias; y[0] *= bflo(uw.x); y[1] *= bfhi(uw.x); y[2] *= bflo(uw.y); y[3] *= bfhi(uw.y);
                acc[mt][nt] = y; sq += (y[0] * y[0] + y[1] * y[1]) + (y[2] * y[2] + y[3] * y[3]);
                if ((nt & 3) == 3) asm volatile("" ::: "memory"); }
            sq += __shfl_xor(sq, 16); sq += __shfl_xor(sq, 32);
            if (fq == 0) part[(ks & 1) * 256 + g * 32 + 16 * mt + fr] = sq; }
        __syncthreads();
#pragma unroll
        for (int mt = 0; mt < 2; ++mt) { float tot = 0.f;
#pragma unroll
            for (int w = 0; w < 8; ++w) tot += part[(ks & 1) * 256 + w * 32 + 16 * mt + fr];
            const float ra = 1.0f / sqrtf(tot * (1.0f / DA) + EPS); const int row = rowbase + 16 * mt + fr;
#pragma unroll
            for (int nt = 0; nt < 8; ++nt) { const int d = g * HD + 16 * nt + 4 * fq; const f32x4 go = *(const f32x4*)(g_oa + d); const f32x4 o = (acc[mt][nt] * ra) * go;
                u32x2 w; w.x = pk2(o[0], o[1]); w.y = pk2(o[2], o[3]); *(u32x2*)(YC + (size_t)row * 2048 + d) = w;
                if ((nt & 3) == 3) asm volatile("" ::: "memory"); } }
        if (ks + 1 < nks) {
#pragma unroll
            for (int i = 0; i < 8; ++i) { const int idx = tid + 512 * i, r = idx >> 7, ch = idx & 127; stg[i] = *(const u32x4*)(UV + (size_t)(chunkrow0 + 32 * (ks + 1) + r) * 2048 + 1024 + 8 * ch); } }
        }
    }
    }
    if (doB)
#pragma unroll 1
    for (int ib = 0; ib < nks; ++ib) {
        const int rowbase = chunkrow0 + 32 * ib, pos0 = pos0c + 32 * ib;
    {
        int c = 2 * tid; asm volatile("" : "+v"(c) :: "memory");
        const bool zero_hist = sbs < 0 && pos0 == 0;
        const bf16* xp = (sbs >= 0 ? (const bf16*)(a.ws + WS_GLUS) + ((size_t)sbs * 62 + 30) * DB : GLU + (size_t)rowbase * DB) + c - 30 * DB;
        unsigned xw[62];
#pragma unroll
        for (int si = 0; si < 62; ++si) { xw[si] = *(const unsigned*)xp; xp += DB; asm volatile("" : "+v"(xp)); }
        f32x2 wk[CW];
#pragma unroll
        for (int k = 0; k < CW; ++k) wk[k] = *(const f32x2*)(w_dw + k * DB + c);
        const f32x2 bd = *(const f32x2*)(b_dw + c), gc = *(const f32x2*)(g_cn + c), bc = *(const f32x2*)(b_cn + c), gb = *(const f32x2*)(g_ob + c);
        f32x2 y[32];
#pragma unroll
        for (int t = 0; t < 32; ++t) y[t] = bd;
#pragma unroll
        for (int si = 0; si < 62; ++si) {
            f32x2 x = (f32x2){bflo(xw[si]), bfhi(xw[si])};
            if (si < 30 && zero_hist) x = (f32x2){0.f, 0.f};
#pragma unroll
            for (int t = (si > 30 ? si - 30 : 0); t <= (si < 31 ? si : 31); ++t) y[t] += wk[si - t] * x;
        }
        { float v1[32], v2[32];
#pragma unroll
          for (int t = 0; t < 32; ++t) { v1[t] = y[t][0] + y[t][1]; v2[t] = y[t][0] * y[t][0] + y[t][1] * y[t][1]; }
          const float r1 = halving_reduce32(v1, lane), r2 = halving_reduce32(v2, lane);
          if ((lane & 1) == 0) { red[wave * 64 + (lane >> 1)] = r1; red[wave * 64 + 32 + (lane >> 1)] = r2; } }
        __syncthreads();
        if (tid < 64) { float sacc = 0.f;
#pragma unroll
            for (int w = 0; w < 8; ++w) sacc += red[w * 64 + tid];
            stat[tid] = sacc; }
        __syncthreads();
        { float v3[32];
#pragma unroll
          for (int t = 0; t < 32; ++t) { const float mean = stat[t] * (1.0f / DB), var = stat[32 + t] * (1.0f / DB) - mean * mean, rstd = 1.0f / sqrtf(var + EPS);
              f32x2 z = ((y[t] - mean) * rstd) * gc + bc; z[0] *= fsigmoid(z[0]); z[1] *= fsigmoid(z[1]); y[t] = z; v3[t] = z[0] * z[0] + z[1] * z[1]; }
          const float r3 = halving_reduce32(v3, lane);
          if ((lane & 1) == 0) red[512 + wave * 32 + (lane >> 1)] = r3; }
        __syncthreads();
        if (tid < 32) { float sacc = 0.f;
#pragma unroll
            for (int w = 0; w < 8; ++w) sacc += red[512 + w * 32 + tid];
            stat[64 + tid] = sacc; }
        __syncthreads();
#pragma unroll
        for (int t = 0; t < 32; ++t) { const float rb = 1.0f / sqrtf(stat[64 + t] * (1.0f / DB) + EPS); const f32x2 o = (y[t] * rb) * gb;
            *(unsigned*)(YC + (size_t)(rowbase + t) * 2048 + DA + c) = pk2(o[0], o[1]); }
    }
        __syncthreads();
    }
}
__device__ __forceinline__ void mixer_phase(const Args& a, LAS unsigned char* lds, int G, int bid, int tid, int wave, int lane) {
    for (int idx = bid; idx < 256 + 2 * NB_S; idx += G) {
        if (idx < 256) { const int b = idx >> 4, ck = idx & 15; mixer_chunk(a, lds, b * SEQ + ck * 128, 4, -1, ck * 128, tid, wave, lane); }
        else { const int h = idx - 256, bs = h >> 1; mixer_chunk(a, lds, MP + 32 * bs, 1, bs, 0, tid, wave, lane, (h & 1) == 0, (h & 1) == 1); }
    }
}


#define XB_TMO      128
#define XB_XCNT(j)  (256  + 64 * (j))
#define XB_XSUB(j)  (1280 + 64 * (j))
#define XB_XGEN(j)  (2304 + 64 * (j))
#define XB_TOP      3328
#define XB_TOPGEN   3392
#define XCD_BAR_WORDS 3456
#define XB_SPIN_CAP (1u << 18)

__device__ __forceinline__ unsigned xb_ld(unsigned* p)              { return __hip_atomic_load(p, __ATOMIC_RELAXED, __HIP_MEMORY_SCOPE_AGENT); }
__device__ __forceinline__ unsigned xb_add(unsigned* p, unsigned v) { return __hip_atomic_fetch_add(p, v, __ATOMIC_RELAXED, __HIP_MEMORY_SCOPE_AGENT); }
__device__ __forceinline__ unsigned xb_xcc_id() { return (unsigned)__builtin_amdgcn_s_getreg((3 << 11) | 20) & 0xFu; }
#define XB_SPIN(cond, bar) do { unsigned _sp = 0; while (cond) { __builtin_amdgcn_s_sleep(1); \
    if ((++_sp & 255u) == 0u) { if (xb_ld(&(bar)[XB_TMO])) break; if (_sp > XB_SPIN_CAP) { atomicAdd(&(bar)[XB_TMO], 1u); break; } } } } while (0)

struct XcdBarrier {
    unsigned* bar; unsigned x;
    volatile LAS unsigned* st;
};

__device__ __forceinline__ XcdBarrier xcd_barrier_post(unsigned* bar, volatile LAS unsigned* st) {
    XcdBarrier b; b.bar = bar; b.x = xb_xcc_id(); b.st = st;
    if (threadIdx.x == 0) (void)xb_add(&bar[XB_XCNT(b.x)], 1u);
    return b;
}
__device__ __forceinline__ void xcd_barrier_complete(unsigned* bar, unsigned x, unsigned& nloc, unsigned& nx) {
    const unsigned G = gridDim.x * gridDim.y * gridDim.z;
    unsigned sum, cnt, mine, sp = 0u;
    for (;;) {
        sum = 0u; cnt = 0u; mine = 0u;
#pragma unroll
        for (unsigned j = 0; j < 16; ++j) { const unsigned c = xb_ld(&bar[XB_XCNT(j)]); sum += c; cnt += (c > 0u) ? 1u : 0u; mine = (j == x) ? c : mine; }
        if (sum == G) break;
        __builtin_amdgcn_s_sleep(1);
        if ((++sp & 255u) == 0u) { if (xb_ld(&bar[XB_TMO])) break; if (sp > XB_SPIN_CAP) { atomicAdd(&bar[XB_TMO], 1u); break; } }
    }
    nloc = mine > 0u ? mine : 1u; nx = cnt > 0u ? cnt : 1u;
}

__device__ __forceinline__ void xcd_barrier(const XcdBarrier& b) {
    asm volatile("s_waitcnt vmcnt(0)" ::: "memory");
    __syncthreads();
    if (threadIdx.x == 0) {
        unsigned* bar = b.bar;
        __builtin_amdgcn_s_waitcnt(0);
        unsigned nloc = b.st[0], nx = b.st[1];
        if (nloc == 0u) { xcd_barrier_complete(bar, b.x, nloc, nx); b.st[0] = nloc; b.st[1] = nx; }
        const unsigned old = xb_add(&bar[XB_XSUB(b.x)], 1u);
        const unsigned gen = old / nloc;
        if (old + 1u == (gen + 1u) * nloc) {
            __builtin_amdgcn_fence(__ATOMIC_RELEASE, "agent");
            asm volatile("s_waitcnt vmcnt(0)" ::: "memory");
            const unsigned og = xb_add(&bar[XB_TOP], 1u);
            const unsigned tg = og / nx;
            if (og + 1u == (tg + 1u) * nx) xb_add(&bar[XB_TOPGEN], 1u);
            else XB_SPIN(xb_ld(&bar[XB_TOPGEN]) == tg, bar);
            __builtin_amdgcn_fence(__ATOMIC_ACQUIRE, "agent");
            xb_add(&bar[XB_XGEN(b.x)], 1u);
            asm volatile("s_waitcnt vmcnt(0)" ::: "memory");
        } else {
            XB_SPIN(xb_ld(&bar[XB_XGEN(b.x)]) == gen, bar);
            __builtin_amdgcn_fence(__ATOMIC_ACQUIRE, "agent");
            asm volatile("s_waitcnt vmcnt(0)" ::: "memory");
        }
    }
    __syncthreads();
}

__global__ void __launch_bounds__(512, 2) mega_fwd(Args a) {
    extern __shared__ __attribute__((aligned(16))) unsigned char lds_raw[];
    LAS unsigned char* lds = (LAS unsigned char*)lds_raw;
    const int G = gridDim.x, bid = blockIdx.x;
#define TIDS const int tid = fresh_tid(), lane = tid & 63, wave = __builtin_amdgcn_readfirstlane(tid >> 6), gw = bid * 8 + wave, ngw = G * 8; (void)gw; (void)ngw; (void)lane
    const int lo = a.ph_lo, hi = a.ph_hi;
    volatile LAS unsigned* MISC = (volatile LAS unsigned*)(lds + LDS_BYTES - 64);
    if (threadIdx.x < 16) MISC[threadIdx.x] = 0u;
    __syncthreads();
    XcdBarrier xbar = xcd_barrier_post((unsigned*)(a.ws + WS_CTL) + 1024, MISC + 8);
    unsigned char* ws = a.ws;
    float* mod = (float*)(ws + WS_MOD);
    bf16* Hb = (bf16*)(ws + WS_H); unsigned char* ACT = ws + WS_ACT;
    bf16* X16 = (bf16*)(ws + WS_X16);
    float* X = a.out; (void)X;
#ifndef PHMASK
#define PHMASK 0xFFF
#endif
#define IN(k) (((PHMASK >> (k)) & 1) && lo <= (k) && (k) < hi)
#define SEAM(k) do { if (IN(k) && IN((k) + 1)) xcd_barrier(xbar); } while (0)
    if (a.ph_hi > 4096) cg::this_grid().sync();
#ifndef DUPMASK
#define DUPMASK 0
#endif
#define REP(k) for (int rep_ = 0; rep_ < 1 + ((DUPMASK >> (k)) & 1); ++rep_)
#define DSYNC(k) do { if (((DUPMASK >> (k)) & 1) && rep_ == 0) xcd_barrier(xbar); } while (0)

    if (IN(0)) REP(0) { TIDS; p0_prologue(a, lds, G, bid, tid, wave, lane); DSYNC(0); }
    SEAM(0);
    if (IN(1)) REP(1) { TIDS; norm_phase<3>(a.in[0], a.in[1], a.in[7], mod, OFF_SH1, OFF_SC1, Hb, gw, ngw, lane, (float*)(ws + WS_RS)); DSYNC(1); }
    SEAM(1);
    if (IN(2)) REP(2) { pg8::Gemm g{Hb, (const bf16*)(ws + WS_WUP1), M, 2 * FF, D}; pg8::MixedOrder S; S.init(MP, 2 * FF, D, 4, G, bid, pg8::WGM, 128); S.rev = 1;     const pg8::SplitK sk{(float*)(ws + WS_PART), (unsigned*)(ws + WS_CTL) + 8192 + 0 * 512};
        pg8::EpiSwiGLU E{ACT, pg8::WI8_DQ, (const float*)(ws + WS_RS)};
        pg8::gemm_phase<pg8::EpiSwiGLU, pg8::MixedOrder, true, true, false, true>(lds, g, S, E, sk); DSYNC(2); }
    SEAM(2);
    if (IN(3)) REP(3) { pg8::Gemm g{(const bf16*)ACT, (const bf16*)(ws + WS_WDN1), M, D, FF}; pg8::MixedOrder S; S.init(MP, D, FF, 11, G, bid, 4, 128); S.rev = 1; const pg8::SplitK sk{(float*)(ws + WS_PART), (unsigned*)(ws + WS_CTL) + 8192 + 1 * 512}; pg8::EpiResT<true> E{a.in[0], a.in[1], X16, mod + OFF_GT1, 0.5f / (pg8::ACT_SCALE * pg8::WDN_SCALE)};
        pg8::gemm_phase<pg8::EpiResT<true>, pg8::MixedOrder, true, true, true>(lds, g, S, E, sk); DSYNC(3); }
    SEAM(3);
    if (IN(4)) REP(4) { TIDS; norm_phase<0, true>(X16, X16 + (size_t)MP * D, a.in[10], mod, OFF_SH2, OFF_SC2, Hb, gw, ngw, lane); DSYNC(4); }
    SEAM(4);
    if (IN(5)) REP(5) { pg8::Gemm g{Hb, (const bf16*)(ws + WS_WIN), M, 4096, D}; pg8::MixedOrder S; S.init(MP, 4096, D, 4, G, bid); S.rev = 1; const pg8::SplitK sk{(float*)(ws + WS_PART), (unsigned*)(ws + WS_CTL) + 8192 + 2 * 512};
        pg8::EpiWin E{(bf16*)(ws + WS_UV), (bf16*)(ws + WS_GLU), (bf16*)(ws + WS_GLUS), a.out + OUT_CP, a.out + OUT_CS};
        pg8::gemm_phase<pg8::EpiWin, pg8::MixedOrder, true, true>(lds, g, S, E, sk); DSYNC(5); }
    SEAM(5);
    if (IN(6)) REP(6) { TIDS; mixer_phase(a, lds, G, bid, tid, wave, lane); DSYNC(6); }
    SEAM(6);
    if (IN(7)) REP(7) { pg8::Gemm g{Hb, (const bf16*)(ws + WS_WOUT), M, D, D}; pg8::MixedOrder S; S.init(MP, D, D, 4, G, bid); const pg8::SplitK sk{(float*)(ws + WS_PART), (unsigned*)(ws + WS_CTL) + 8192 + 3 * 512}; pg8::EpiResT<false> E{X16, X16 + (size_t)MP * D, X16, mod + OFF_GT2, 1.0f};
        pg8::gemm_phase<pg8::EpiResT<false>, pg8::MixedOrder, true, true>(lds, g, S, E, sk); DSYNC(7); }
    SEAM(7);
    if (IN(8)) REP(8) { TIDS; norm_phase<3, true>(X16, X16 + (size_t)MP * D, a.in[22], mod, OFF_SH3, OFF_SC3, Hb, gw, ngw, lane, (float*)(ws + WS_RS) + M); DSYNC(8); }
    SEAM(8);
    if (IN(9)) REP(9) { pg8::Gemm g{Hb, (const bf16*)(ws + WS_WUP2), M, 2 * FF, D}; pg8::MixedOrder S; S.init(MP, 2 * FF, D, 4, G, bid, pg8::WGM, 128); S.rev = 1;     const pg8::SplitK sk{(float*)(ws + WS_PART), (unsigned*)(ws + WS_CTL) + 8192 + 4 * 512};
        pg8::EpiSwiGLU E{ACT, pg8::WI8_DQ, (const float*)(ws + WS_RS) + M};
        pg8::gemm_phase<pg8::EpiSwiGLU, pg8::MixedOrder, true, true, false, true>(lds, g, S, E, sk); DSYNC(9); }
    SEAM(9);
    if (IN(10)) REP(10) { pg8::Gemm g{(const bf16*)ACT, (const bf16*)(ws + WS_WDN2), M, D, FF}; pg8::MixedOrder S; S.init(MP, D, FF, 11, G, bid, 4, 128); S.rev = 1; const pg8::SplitK sk{(float*)(ws + WS_PART), (unsigned*)(ws + WS_CTL) + 8192 + 5 * 512}; pg8::EpiResT<false> E{X16, X16 + (size_t)MP * D, X16, mod + OFF_GT3, 0.5f / (pg8::ACT_SCALE * pg8::WDN_SCALE)};
        pg8::gemm_phase<pg8::EpiResT<false>, pg8::MixedOrder, true, true, true>(lds, g, S, E, sk); DSYNC(10); }
    SEAM(10);
    if (IN(11)) REP(11) { TIDS; norm_phase<1, true>(X16, X16 + (size_t)MP * D, a.in[25], mod, 0, 0, a.out, gw, ngw, lane); }
#undef IN
#undef SEAM
}

extern "C" void kernel_launch(void* const* d_in, const int* in_sizes, int n_in, void* d_out, int out_size, void* d_ws, size_t ws_size, hipStream_t stream) {
    static int grid = 0;
    if (grid == 0) {
        if (n_in != 26 || in_sizes[0] != MP * D || (size_t)out_size != OUT_END || ws_size < WS_END) {
            fprintf(stderr, "kernel_launch: unexpected shapes (n_in %d, in0 %d, out %d, ws %zu); nothing launched\n", n_in, n_in > 0 ? in_sizes[0] : -1, out_size, ws_size); grid = -1; return; }
        int dev = 0, cus = 0, per_cu = 0;
        if (hipGetDevice(&dev) != hipSuccess || hipDeviceGetAttribute(&cus, hipDeviceAttributeMultiprocessorCount, dev) != hipSuccess) { grid = -1; return; }
        if (hipFuncSetAttribute((const void*)mega_fwd, hipFuncAttributeMaxDynamicSharedMemorySize, LDS_BYTES) != hipSuccess) { fprintf(stderr, "kernel_launch: hipFuncSetAttribute failed\n"); grid = -1; return; }
        if (hipOccupancyMaxActiveBlocksPerMultiprocessor(&per_cu, (const void*)mega_fwd, 512, LDS_BYTES) != hipSuccess || per_cu < 1) { fprintf(stderr, "kernel_launch: occupancy query says %d\n", per_cu); per_cu = 1; }
        (void)hipGetLastError();
        grid = cus * per_cu;
    }
    if (grid < 0) return;
    if (hipMemsetAsync((char*)d_ws + WS_CTL, 0, CTL_BYTES, stream) != hipSuccess) { fprintf(stderr, "kernel_launch: memset failed\n"); return; }
    Args a{};
    for (int i = 0; i < 26; ++i) a.in[i] = (const float*)d_in[i];
    a.out = (float*)d_out; a.ws = (unsigned char*)d_ws;
#if MK_PER_PHASE
    for (int ph = 0; ph < NPH; ++ph) { a.ph_lo = ph; a.ph_hi = ph + 1; hipLaunchKernelGGL(mega_fwd, dim3(grid), dim3(512), LDS_BYTES, stream, a); }
#else
    a.ph_lo = 0; a.ph_hi = NPH;
    void* args[] = {&a};
    hipError_t e = hipLaunchCooperativeKernel((const void*)mega_fwd, dim3(grid), dim3(512), args, LDS_BYTES, stream);
    if (e != hipSuccess) fprintf(stderr, "kernel_launch: cooperative launch failed: %s (grid %d)\n", hipGetErrorString(e), grid);
#endif
}
```
